# Optimizing an MI355X kernel written in HIP

```python
import math
import jax, jax.numpy as jnp
from jax import lax
import numpy as np

D_MODEL = 4096
BATCH = 4
SEQ = 2048
DEPTH = 1

A_KDIM = 128
A_VDIM = 128
A_WIDTH = D_MODEL // 2
A_HEADS = A_WIDTH // A_VDIM
A_KWIDTH = A_HEADS * A_KDIM
CHUNK = 64

B_HEAD_DIM = 128
B_WIDTH = D_MODEL // 2
B_HEADS = B_WIDTH // (2 * B_HEAD_DIM)
B_QK_WIDTH = B_HEADS * 2 * B_HEAD_DIM
Q_BLOCK = 128

NORM_EPS = 1e-6
SUBLN_EPS = 1e-5
NEG_INF = -1e30

kernel_name = "hgrn2_diffattn_gated_hybrid"


def rmsnorm(x, w, eps=NORM_EPS):
    xf = x.astype(jnp.float32)
    y = xf * lax.rsqrt(jnp.mean(xf * xf, axis=-1, keepdims=True) + eps) * w.astype(jnp.float32)
    return y.astype(x.dtype)


def hgrn2_mix(q, f_logit, i, lb):
    bsz, seq, _ = q.shape
    n_chunks = seq // CHUNK
    z = f_logit.astype(jnp.float32)
    lb = lb.astype(jnp.float32)
    log_f = jnp.log(lb + (1.0 - lb) * jax.nn.sigmoid(z))
    k = (1.0 - lb) * jax.nn.sigmoid(-z)

    def heads(t, d):
        return t.astype(jnp.float32).reshape(bsz, n_chunks, CHUNK, A_HEADS, d).transpose(0, 3, 1, 2, 4)

    qh, kh, lfh = heads(q, A_KDIM), heads(k, A_KDIM), heads(log_f, A_KDIM)
    vh = heads(i, A_VDIM)
    b = jnp.cumsum(lfh, axis=3)
    q_dec = qh * jnp.exp(b)
    k_inv = kh * jnp.exp(-b)
    causal = jnp.tril(jnp.ones((CHUNK, CHUNK), dtype=bool))
    scores = jnp.einsum('bhnck,bhnsk->bhncs', q_dec, k_inv)
    scores = jnp.where(causal, scores, 0.0)
    o_intra = jnp.einsum('bhncs,bhnsv->bhncv', scores, vh)

    b_last = b[:, :, :, -1:, :]
    k_to_end = kh * jnp.exp(b_last - b)
    chunk_state = jnp.einsum('bhnsk,bhnsv->bhnkv', k_to_end, vh)
    chunk_decay = jnp.exp(b_last[:, :, :, 0, :])

    def step(s_prev, inp):
        decay, upd = inp
        return decay[..., None] * s_prev + upd, s_prev

    s0 = jnp.zeros((bsz, A_HEADS, A_KDIM, A_VDIM), jnp.float32)
    _, s_in = lax.scan(step, s0, (chunk_decay.transpose(2, 0, 1, 3),
                                  chunk_state.transpose(2, 0, 1, 3, 4)))
    s_in = s_in.transpose(1, 2, 0, 3, 4)
    o_inter = jnp.einsum('bhnck,bhnkv->bhncv', q_dec, s_in)
    o = o_intra + o_inter
    return o.transpose(0, 2, 3, 1, 4).reshape(bsz, seq, A_HEADS, A_VDIM)


def diff_attention(q, k, v, lam, slopes):
    bsz, n_heads, _, seq, hd = q.shape
    n_blocks = seq // Q_BLOCK
    scale = hd ** -0.5
    q_blocks = q.reshape(bsz, n_heads, 2, n_blocks, Q_BLOCK, hd).transpose(3, 0, 1, 2, 4, 5)
    k_pos = jnp.arange(seq)

    def block(args):
        q_blk, blk_idx = args
        q_pos = blk_idx * Q_BLOCK + jnp.arange(Q_BLOCK)
        s = jnp.einsum('bhiqd,bhisd->bhiqs', q_blk, k).astype(jnp.float32) * scale
        dist = q_pos[:, None] - k_pos[None, :]
        bias = -slopes.astype(jnp.float32)[:, None, None] * dist.astype(jnp.float32)
        s = jnp.where(dist >= 0, s + bias[None, :, None], NEG_INF)
        p = jax.nn.softmax(s, axis=-1)
        a = p[:, :, 0] - lam * p[:, :, 1]
        return jnp.einsum('bhqs,bhsv->bhqv', a.astype(v.dtype), v)

    out = lax.map(block, (q_blocks, jnp.arange(n_blocks)))
    return out.transpose(1, 0, 3, 2, 4).reshape(bsz, seq, n_heads, 2 * hd)


def setup_inputs(seed: int = 0) -> dict:
    key = jax.random.key(seed)
    ks = jax.random.split(key, 16)
    n_in = 2 * A_KWIDTH + 2 * A_WIDTH + 2 * B_QK_WIDTH + 2 * B_WIDTH + 2 * D_MODEL
    f32 = jnp.float32
    return {
        "x": jax.random.normal(ks[0], (BATCH, SEQ, D_MODEL), f32),
        "norm_w": 1.0 + 0.02 * jax.random.normal(ks[1], (DEPTH, D_MODEL), f32),
        "w_in": jax.random.normal(ks[2], (DEPTH, D_MODEL, n_in), f32) * D_MODEL ** -0.5,
        "lower_bound_table": 1.0 + 0.1 * jax.random.normal(ks[3], (DEPTH + 1, A_KWIDTH), f32),
        "hgrn_norm_w": 1.0 + 0.02 * jax.random.normal(ks[4], (DEPTH, A_VDIM), f32),
        "lambda_q1": 0.1 * jax.random.normal(ks[5], (DEPTH, B_HEAD_DIM), f32),
        "lambda_k1": 0.1 * jax.random.normal(ks[6], (DEPTH, B_HEAD_DIM), f32),
        "lambda_q2": 0.1 * jax.random.normal(ks[7], (DEPTH, B_HEAD_DIM), f32),
        "lambda_k2": 0.1 * jax.random.normal(ks[8], (DEPTH, B_HEAD_DIM), f32),
        "subln_w": 1.0 + 0.02 * jax.random.normal(ks[9], (DEPTH, 2 * B_HEAD_DIM), f32),
        "w_branch_a": jax.random.normal(ks[10], (DEPTH, A_WIDTH, D_MODEL), f32) * A_WIDTH ** -0.5,
        "w_branch_b": jax.random.normal(ks[11], (DEPTH, B_WIDTH, D_MODEL), f32) * B_WIDTH ** -0.5,
        "w_out": jax.random.normal(ks[12], (DEPTH, D_MODEL, D_MODEL), f32) * D_MODEL ** -0.5,
        "final_w": 1.0 + 0.02 * jax.random.normal(ks[13], (D_MODEL,), f32),
    }


def reference(x, norm_w, w_in, lower_bound_table, hgrn_norm_w, lambda_q1, lambda_k1,
              lambda_q2, lambda_k2, subln_w, w_branch_a, w_branch_b, w_out, final_w):
    bsz, seq, _ = x.shape
    sizes = [A_KWIDTH, A_KWIDTH, A_WIDTH, A_WIDTH,
             B_QK_WIDTH, B_QK_WIDTH, B_WIDTH, B_WIDTH, D_MODEL, D_MODEL]
    split_idx = [int(s) for s in np.cumsum(sizes)[:-1]]
    lb_all = jnp.cumsum(jax.nn.softmax(lower_bound_table.astype(jnp.float32), axis=0), axis=0)
    slopes = jnp.exp2(-8.0 * (jnp.arange(B_HEADS, dtype=jnp.float32) + 1.0) / B_HEADS)

    h = x
    for l in range(DEPTH):
        u = rmsnorm(h, norm_w[l])
        proj = u @ w_in[l]
        a_q, a_f, a_i, a_g, b_q, b_k, b_v, b_g, gate_a, gate_b = jnp.split(proj, split_idx, axis=-1)

        o_a = hgrn2_mix(a_q, a_f, a_i, lb_all[l]).astype(u.dtype)
        o_a = rmsnorm(o_a, hgrn_norm_w[l]).reshape(bsz, seq, A_WIDTH) * jax.nn.silu(a_g)

        lam_init = 0.8 - 0.6 * math.exp(-0.3 * l)
        lam = (jnp.exp(jnp.sum(lambda_q1[l].astype(jnp.float32) * lambda_k1[l].astype(jnp.float32)))
               - jnp.exp(jnp.sum(lambda_q2[l].astype(jnp.float32) * lambda_k2[l].astype(jnp.float32)))
               + lam_init)
        qb = b_q.reshape(bsz, seq, B_HEADS, 2, B_HEAD_DIM).transpose(0, 2, 3, 1, 4)
        kb = b_k.reshape(bsz, seq, B_HEADS, 2, B_HEAD_DIM).transpose(0, 2, 3, 1, 4)
        vb = b_v.reshape(bsz, seq, B_HEADS, 2 * B_HEAD_DIM).transpose(0, 2, 1, 3)
        o_b = diff_attention(qb, kb, vb, lam, slopes)
        o_b = rmsnorm(o_b, subln_w[l], SUBLN_EPS) * (1.0 - lam_init)
        o_b = o_b.reshape(bsz, seq, B_WIDTH) * jax.nn.silu(b_g)

        y = (jax.nn.sigmoid(gate_a) * (o_a @ w_branch_a[l])
             + jax.nn.sigmoid(gate_b) * (o_b @ w_branch_b[l]))
        h = h + y @ w_out[l]
    return rmsnorm(h, final_w)
```

```cpp
#include <hip/hip_runtime.h>
#include <hip/hip_cooperative_groups.h>
#include <cstdio>
#include <cstdint>
namespace cg = cooperative_groups;

#ifndef MK_N_LAUNCHES
#define MK_N_LAUNCHES 1
#endif
#ifndef PROBE_PH
#define PROBE_PH -1
#endif

constexpr int DM = 4096, BATCH = 4, SEQ = 2048, MT = BATCH * SEQ, NIN = 24576;
constexpr int C_AQ = 0, C_AF = 2048, C_AI = 4096, C_AG = 6144, C_BQ = 8192, C_BK = 10240, C_BV = 12288, C_BG = 14336, C_GA = 16384, C_GB = 20480;
constexpr int AW = 2048;

namespace pg8 {
#define PG8_LAS __attribute__((address_space(3)))
typedef unsigned short bf16_t;
typedef short bf16x8 __attribute__((ext_vector_type(8)));
typedef float f32x4 __attribute__((ext_vector_type(4)));
typedef unsigned u32x4 __attribute__((ext_vector_type(4)));
constexpr int BM = 256, BK = 64, HALF = 128, HTB = HALF * BK * 2  , STAGE_BYTES = 8 * HTB, NXCD = 8, WGM = 8;

__host__ __device__ __forceinline__ int lds_byte(int r, int c) { const int st = (r >> 4) * 2 + (c >> 5), rr = r & 15, cc = c & 31, ob = rr * 64 + cc * 2; return st * 1024 + (ob ^ (((ob >> 9) & 1) << 5)); }
__host__ __device__ __forceinline__ void stage_rc(int b, int& R, int& C) { const int st = b / 1024, sb = b % 1024, swz = sb ^ (((sb >> 9) & 1) << 5); R = (st >> 1) * 16 + swz / 64; C = (st & 1) * 32 + (swz % 64) / 2; }
__host__ __device__ __forceinline__ int perm32(int rho) { const int n = rho >> 4, i = rho & 15; return 8 * (i >> 2) + 4 * n + (i & 3); }

struct Unit { int pm, pn, half; };
struct Gemm { const bf16_t* A; const bf16_t* Bt; const bf16_t* A2; const bf16_t* Bt2; int K; };

struct StaticOrder {
    int nM, nN, nwg, G, c, rep;
    __host__ __device__ void init(int M, int N, int G_, int c_, int rep_ = 1) { nM = M / BM; nN = N / BM; nwg = nM * nN; G = G_; c = c_; rep = rep_; }
    __host__ __device__ bool next(int i, Unit& u) const {
        u.half = 0;
        const int R = (nwg + G - 1) / G; if (i >= R * rep) return false; i = i % R;
        const long L = (long)i * G + c; if (L >= nwg) return false;
        int wgid = (int)L; { const int q = nwg / NXCD, r = nwg % NXCD, xcd = wgid % NXCD, off = wgid / NXCD; wgid = (xcd < r ? xcd * (q + 1) : r * (q + 1) + (xcd - r) * q) + off; }
        const int nig = WGM * nN, gid = wgid / nig, fm = gid * WGM, gsz = (nM - fm) < WGM ? (nM - fm) : WGM;
        u.pm = fm + ((wgid % nig) % gsz); u.pn = (wgid % nig) / gsz; return true;
    }
};
struct ChainOrder : StaticOrder {
    __host__ __device__ bool next(int i, Unit& u) const { const bool ok = StaticOrder::next(i >> 1, u); u.half = i & 1; return ok; }
};

typedef __bf16 bf16x2h __attribute__((ext_vector_type(2)));
typedef float f32x2h __attribute__((ext_vector_type(2)));
__device__ __forceinline__ unsigned cvt_pk_bf16(float lo, float hi) { const bf16x2h v = __builtin_convertvector((f32x2h){lo, hi}, bf16x2h); return __builtin_bit_cast(unsigned, v); }
__device__ __forceinline__ float bf_lo(unsigned w) { return __uint_as_float(w << 16); }
__device__ __forceinline__ float bf_hi(unsigned w) { return __uint_as_float(w & 0xffff0000u); }

struct EpiProj {
    static constexpr bool PERM = true;
    bf16_t* O; int ldc; int col_off; float scale; int sig;
    __device__ __forceinline__ bool operator()(f32x4 (&acc)[2][2][4][2], const Unit& u, int wr, int wc, int fr, int fq) const {
        const int row0 = u.pm * BM + wr * 64 + fr, col0 = col_off + u.pn * BM + wc * 32 + 8 * fq;
#pragma unroll
        for (int ai = 0; ai < 2; ++ai)
#pragma unroll
            for (int m = 0; m < 4; ++m) { bf16_t* rowp = O + (size_t)(row0 + ai * HALF + m * 16) * ldc + col0;
#pragma unroll
                for (int bj = 0; bj < 2; ++bj) { f32x4 v0 = acc[ai][bj][m][0] * scale, v1 = acc[ai][bj][m][1] * scale;
                    if (sig) {
#pragma unroll
                        for (int j = 0; j < 4; ++j) { v0[j] = __builtin_amdgcn_rcpf(1.f + __expf(-v0[j])); v1[j] = __builtin_amdgcn_rcpf(1.f + __expf(-v1[j])); } }
                    u32x4 w; w.x = cvt_pk_bf16(v0[0], v0[1]); w.y = cvt_pk_bf16(v0[2], v0[3]); w.z = cvt_pk_bf16(v1[0], v1[1]); w.w = cvt_pk_bf16(v1[2], v1[3]);
                    if (sig) __builtin_nontemporal_store(w, (u32x4*)(rowp + bj * HALF)); else *(u32x4*)(rowp + bj * HALF) = w; } }
        return false;
    }
};
struct EpiMerge {
    static constexpr bool PERM = true;
    const bf16_t* P; bf16_t* Y;
    __device__ __forceinline__ bool operator()(f32x4 (&acc)[2][2][4][2], const Unit& u, int wr, int wc, int fr, int fq) const {
        const int row0 = u.pm * BM + wr * 64 + fr, col0 = u.pn * BM + wc * 32 + 8 * fq;
#pragma unroll
        for (int ai = 0; ai < 2; ++ai)
#pragma unroll
            for (int m = 0; m < 4; ++m) { const size_t r = (size_t)(row0 + ai * HALF + m * 16);
#pragma unroll
                for (int bj = 0; bj < 2; ++bj) { const int c = col0 + bj * HALF;
                    const u32x4 gb = __builtin_nontemporal_load((const u32x4*)(P + r * NIN + C_GB + c));
                    float sb[8]; sb[0] = bf_lo(gb.x); sb[1] = bf_hi(gb.x); sb[2] = bf_lo(gb.y); sb[3] = bf_hi(gb.y); sb[4] = bf_lo(gb.z); sb[5] = bf_hi(gb.z); sb[6] = bf_lo(gb.w); sb[7] = bf_hi(gb.w);
                    if (u.half == 0) {
                        const u32x4 ga = __builtin_nontemporal_load((const u32x4*)(P + r * NIN + C_GA + c));
                        float sa[8]; sa[0] = bf_lo(ga.x); sa[1] = bf_hi(ga.x); sa[2] = bf_lo(ga.y); sa[3] = bf_hi(ga.y); sa[4] = bf_lo(ga.z); sa[5] = bf_hi(ga.z); sa[6] = bf_lo(ga.w); sa[7] = bf_hi(ga.w);
#pragma unroll
                        for (int j = 0; j < 4; ++j) { acc[ai][bj][m][0][j] *= sa[j] * __builtin_amdgcn_rcpf(sb[j]); acc[ai][bj][m][1][j] *= sa[4 + j] * __builtin_amdgcn_rcpf(sb[4 + j]); }
                    } else {
                        float y[8];
#pragma unroll
                        for (int j = 0; j < 4; ++j) { y[j] = acc[ai][bj][m][0][j] * sb[j]; y[4 + j] = acc[ai][bj][m][1][j] * sb[4 + j]; }
                        u32x4 w; w.x = cvt_pk_bf16(y[0], y[1]); w.y = cvt_pk_bf16(y[2], y[3]); w.z = cvt_pk_bf16(y[4], y[5]); w.w = cvt_pk_bf16(y[6], y[7]);
                        *(u32x4*)(Y + r * DM + c) = w;
                    } } }
        return u.half == 0;
    }
};
struct EpiResid {
    static constexpr bool PERM = false;
    const float* X; float* O;
    __device__ __forceinline__ bool operator()(f32x4 (&acc)[2][2][4][2], const Unit& u, int wr, int wc, int fr, int fq) const {
        const int row0 = u.pm * BM + wr * 64 + fr, col0 = u.pn * BM + wc * 32 + 4 * fq;
#pragma unroll
        for (int ai = 0; ai < 2; ++ai)
#pragma unroll
            for (int m = 0; m < 4; ++m) { const size_t off = (size_t)(row0 + ai * HALF + m * 16) * DM + col0;
#pragma unroll
                for (int bj = 0; bj < 2; ++bj)
#pragma unroll
                    for (int n = 0; n < 2; ++n) { const f32x4 xv = *(const f32x4*)(X + off + bj * HALF + n * 16); *(f32x4*)(O + off + bj * HALF + n * 16) = xv + acc[ai][bj][m][n]; } }
        return false;
    }
};

typedef int i32x4v __attribute__((ext_vector_type(4)));
typedef int i32x8v __attribute__((ext_vector_type(8)));
template <class Epi, class Sched, bool ALIGN_EPI = false, bool SP2 = false, bool FP8 = false>
__device__ __forceinline__ void gemm_phase(PG8_LAS unsigned char* lds, const Gemm g, const Sched& S, const Epi& E) {
    const int tid = threadIdx.x, wid = __builtin_amdgcn_readfirstlane(tid >> 6), lane = tid & 63, wr = wid >> 2, wc = wid & 3, fr = lane & 15, fq = lane >> 4;
    const int K = g.K, nt = K / BK;
    unsigned voffA[2], voffB[2];
#pragma unroll
    for (int i = 0; i < 2; ++i) { int R, C; stage_rc(tid * 16 + i * 8192, R, C); const int Rb = Epi::PERM ? ((R & ~31) + perm32(R & 31)) : R;
        voffA[i] = (unsigned)(R * K + C) * 2u; voffB[i] = (unsigned)(Rb * K + C) * 2u; }
    const size_t kstep = (size_t)(BK * 2);
    const size_t hstep = (size_t)HALF * K * 2;
    const size_t tstep = 2 * hstep;
    const unsigned ldsw = (unsigned)wid * 1024u;
    const int aoff = lds_byte(wr * 64 + fr, fq * 8), boff = lds_byte(wc * 32 + fr, fq * 8);
#define PG8_SA(b, h) (((b) * 2 + (h)) * HTB)
#define PG8_SB(b, h) ((4 + (b) * 2 + (h)) * HTB)
#define PG8_STAGE(bufoff, gbase, voff) do { _Pragma("unroll") for (int _i = 0; _i < 2; ++_i) \
        __builtin_amdgcn_global_load_lds((const unsigned*)((const char*)(gbase) + (voff)[_i]), (PG8_LAS unsigned*)(lds + (bufoff) + ldsw + _i * 8192), 16, 0, 0); } while (0)
#define PG8_CAT8(lo_, hi_) __builtin_shufflevector(__builtin_bit_cast(i32x4v, lo_), __builtin_bit_cast(i32x4v, hi_), 0, 1, 2, 3, 4, 5, 6, 7)
#define PG8_LDA(dst, b, h) do { _Pragma("unroll") for (int m = 0; m < 4; ++m) { const bf16x8 lo_ = *(const PG8_LAS bf16x8*)(lds + PG8_SA(b, h) + aoff + m * 2048), hi_ = *(const PG8_LAS bf16x8*)(lds + PG8_SA(b, h) + aoff + m * 2048 + 1024); \
        if constexpr (FP8) dst##8[m] = PG8_CAT8(lo_, hi_); else { dst[m][0] = lo_; dst[m][1] = hi_; } } } while (0)
#define PG8_LDB(dst, b, h) do { _Pragma("unroll") for (int n = 0; n < 2; ++n) { const bf16x8 lo_ = *(const PG8_LAS bf16x8*)(lds + PG8_SB(b, h) + boff + n * 2048), hi_ = *(const PG8_LAS bf16x8*)(lds + PG8_SB(b, h) + boff + n * 2048 + 1024); \
        if constexpr (FP8) dst##8[n] = PG8_CAT8(lo_, hi_); else { dst[n][0] = lo_; dst[n][1] = hi_; } } } while (0)
#define PG8_MMA(ai, bj, At, Bt) do { __builtin_amdgcn_s_setprio(1); \
        if constexpr (FP8) { _Pragma("unroll") for (int m = 0; m < 4; ++m) _Pragma("unroll") for (int n = 0; n < 2; ++n) \
            asm volatile("v_mfma_scale_f32_16x16x128_f8f6f4 %0, %1, %2, %0, %3, %3 op_sel_hi:[0,0,0]" : "+v"(acc[ai][bj][m][n]) : "v"(Bt##8[n]), "v"(At##8[m]), "v"(mxone)); \
        } else { _Pragma("unroll") for (int m = 0; m < 4; ++m) _Pragma("unroll") for (int n = 0; n < 2; ++n) _Pragma("unroll") for (int k = 0; k < 2; ++k) \
            acc[ai][bj][m][n] = __builtin_amdgcn_mfma_f32_16x16x32_bf16(Bt[n][k], At[m][k], acc[ai][bj][m][n], 0, 0, 0); } \
        __builtin_amdgcn_s_setprio(0); } while (0)
#define PG8_WAIT_V(n) asm volatile("s_waitcnt vmcnt(" #n ")" ::: "memory")
#define PG8_WAIT_L(n) asm volatile("s_waitcnt lgkmcnt(" #n ")" ::: "memory")
#define PG8_BAR __builtin_amdgcn_s_barrier()
#define PG8_SCHED __builtin_amdgcn_sched_barrier(0)
    Unit cur, nxt; int ui = 0;
    if (!S.next(0, cur)) return;
    f32x4 acc[2][2][4][2];
#pragma unroll
    for (int a = 0; a < 2; ++a)
#pragma unroll
        for (int b = 0; b < 2; ++b)
#pragma unroll
            for (int m = 0; m < 4; ++m)
#pragma unroll
                for (int n = 0; n < 2; ++n) acc[a][b][m][n] = (f32x4){0.f, 0.f, 0.f, 0.f};
    bf16x8 At[4][2], B0[2][2], B1[2][2];
    const int mxone = 0x7f7f7f7f;
    i32x8v At8[4], B08[2], B18[2];
    const char* cA = (const char*)(cur.half ? g.A2 : g.A) + (size_t)cur.pm * tstep; const char* cB = (const char*)(cur.half ? g.Bt2 : g.Bt) + (size_t)cur.pn * tstep;
    if constexpr (SP2) {
        PG8_STAGE(PG8_SB(0, 0), cB, voffB); PG8_STAGE(PG8_SB(0, 1), cB + hstep, voffB); PG8_STAGE(PG8_SA(0, 0), cA, voffA); PG8_STAGE(PG8_SA(0, 1), cA + hstep, voffA);
        if (wr == 1) PG8_BAR;
        PG8_WAIT_V(2); PG8_BAR;
        PG8_STAGE(PG8_SB(1, 0), cB + kstep, voffB); PG8_STAGE(PG8_SA(1, 0), cA + kstep, voffA); PG8_STAGE(PG8_SB(1, 1), cB + hstep + kstep, voffB);
        PG8_WAIT_V(6); PG8_BAR;
    } else {
        PG8_STAGE(PG8_SB(0, 0), cB, voffB); PG8_STAGE(PG8_SA(0, 0), cA, voffA); PG8_STAGE(PG8_SB(0, 1), cB + hstep, voffB); PG8_STAGE(PG8_SA(0, 1), cA + hstep, voffA);
        if (wr == 1) PG8_BAR;
        PG8_WAIT_V(4); PG8_BAR;
        PG8_STAGE(PG8_SB(1, 0), cB + kstep, voffB); PG8_STAGE(PG8_SA(1, 0), cA + kstep, voffA); PG8_STAGE(PG8_SB(1, 1), cB + hstep + kstep, voffB);
        PG8_WAIT_V(6); PG8_BAR;
    }
    for (;;) {
        const bool has_next = S.next(ui + 1, nxt);
        const char* nA = has_next ? (const char*)(nxt.half ? g.A2 : g.A) + (size_t)nxt.pm * tstep : cA; const char* nB = has_next ? (const char*)(nxt.half ? g.Bt2 : g.Bt) + (size_t)nxt.pn * tstep : cB;
        for (int t = 0; t < nt; t += 2) {
            const bool last = (t == nt - 2);
            const char* a1 = cA + (size_t)(t + 1) * kstep;
            const char* a2 = last ? nA : cA + (size_t)(t + 2) * kstep; const char* b2 = last ? nB : cB + (size_t)(t + 2) * kstep;
            const char* a3 = a2 + kstep; const char* b3 = b2 + kstep;
            if constexpr (SP2) {
            PG8_LDB(B0, 0, 0); PG8_LDB(B1, 0, 1); PG8_SCHED; PG8_LDA(At, 0, 0); PG8_STAGE(PG8_SA(1, 1), a1 + hstep, voffA);
            PG8_WAIT_V(8); PG8_WAIT_L(0); PG8_BAR; PG8_MMA(0, 0, At, B0); PG8_MMA(0, 1, At, B1); PG8_BAR; PG8_SCHED;
            PG8_LDA(At, 0, 1); PG8_STAGE(PG8_SB(0, 0), b2, voffB); PG8_STAGE(PG8_SB(0, 1), b2 + hstep, voffB); PG8_STAGE(PG8_SA(0, 0), a2, voffA);
            PG8_WAIT_V(8); PG8_WAIT_L(0); PG8_BAR; PG8_MMA(1, 0, At, B0); PG8_MMA(1, 1, At, B1); PG8_BAR; PG8_SCHED;
            PG8_LDB(B0, 1, 0); PG8_LDB(B1, 1, 1); PG8_SCHED; PG8_LDA(At, 1, 0); PG8_STAGE(PG8_SA(0, 1), a2 + hstep, voffA);
            PG8_WAIT_V(8); PG8_WAIT_L(0); PG8_BAR; PG8_MMA(0, 0, At, B0); PG8_MMA(0, 1, At, B1); PG8_BAR; PG8_SCHED;
            PG8_LDA(At, 1, 1); PG8_STAGE(PG8_SB(1, 0), b3, voffB); PG8_STAGE(PG8_SB(1, 1), b3 + hstep, voffB); PG8_STAGE(PG8_SA(1, 0), a3, voffA);
            PG8_WAIT_V(8); PG8_WAIT_L(0); PG8_BAR; PG8_MMA(1, 0, At, B0); PG8_MMA(1, 1, At, B1); PG8_BAR; PG8_SCHED;
            } else {
            PG8_LDB(B0, 0, 0); PG8_SCHED; PG8_LDA(At, 0, 0); PG8_STAGE(PG8_SA(1, 1), a1 + hstep, voffA);
            PG8_WAIT_L(8); PG8_BAR; PG8_WAIT_L(0); PG8_MMA(0, 0, At, B0); PG8_BAR; PG8_SCHED;
            PG8_LDB(B1, 0, 1); PG8_STAGE(PG8_SB(0, 0), b2, voffB);
            PG8_BAR; PG8_WAIT_L(0); PG8_MMA(0, 1, At, B1); PG8_BAR;
            PG8_LDA(At, 0, 1); PG8_STAGE(PG8_SA(0, 0), a2, voffA);
            PG8_BAR; PG8_WAIT_L(0); PG8_MMA(1, 0, At, B0); PG8_BAR; PG8_SCHED;
            PG8_STAGE(PG8_SB(0, 1), b2 + hstep, voffB);
            PG8_WAIT_V(6); PG8_BAR; PG8_MMA(1, 1, At, B1); PG8_BAR;
            PG8_LDB(B0, 1, 0); PG8_SCHED; PG8_LDA(At, 1, 0); PG8_STAGE(PG8_SA(0, 1), a2 + hstep, voffA);
            PG8_WAIT_L(8); PG8_BAR; PG8_WAIT_L(0); PG8_MMA(0, 0, At, B0); PG8_BAR; PG8_SCHED;
            PG8_LDB(B1, 1, 1); PG8_STAGE(PG8_SB(1, 0), b3, voffB);
            PG8_BAR; PG8_WAIT_L(0); PG8_MMA(0, 1, At, B1); PG8_BAR;
            PG8_LDA(At, 1, 1); PG8_STAGE(PG8_SA(1, 0), a3, voffA);
            PG8_BAR; PG8_WAIT_L(0); PG8_MMA(1, 0, At, B0); PG8_BAR; PG8_SCHED;
            PG8_STAGE(PG8_SB(1, 1), b3 + hstep, voffB);
            PG8_WAIT_V(6); PG8_BAR; PG8_MMA(1, 1, At, B1); PG8_BAR;
            }
        }
        if constexpr (ALIGN_EPI) { if (wr == 0) PG8_BAR; }
        if constexpr (FP8) {
            asm volatile("s_nop 15\n\ts_nop 15" ::: "memory");
#pragma unroll
            for (int a = 0; a < 2; ++a)
#pragma unroll
                for (int b = 0; b < 2; ++b)
#pragma unroll
                    for (int m = 0; m < 4; ++m)
#pragma unroll
                        for (int n = 0; n < 2; ++n) asm volatile("" : "+v"(acc[a][b][m][n]));
        }
        const bool keep = E(acc, cur, wr, wc, fr, fq);
        if (!has_next) break;
        if (!keep)
#pragma unroll
        for (int a = 0; a < 2; ++a)
#pragma unroll
            for (int b = 0; b < 2; ++b)
#pragma unroll
                for (int m = 0; m < 4; ++m)
#pragma unroll
                    for (int n = 0; n < 2; ++n) acc[a][b][m][n] = (f32x4){0.f, 0.f, 0.f, 0.f};
        cur = nxt; cA = nA; cB = nB; ++ui;
        if constexpr (ALIGN_EPI) { if (wr == 1) PG8_BAR; }
    }
    PG8_WAIT_V(0);
    if constexpr (!ALIGN_EPI) { if (wr == 0) PG8_BAR; }
    PG8_BAR;
#undef PG8_SA
#undef PG8_SB
#undef PG8_STAGE
#undef PG8_LDA
#undef PG8_CAT8
#undef PG8_LDB
#undef PG8_MMA
#undef PG8_WAIT_V
#undef PG8_WAIT_L
#undef PG8_BAR
#undef PG8_SCHED
}}

#define LAS __attribute__((address_space(3)))
typedef unsigned short bf16_t;
typedef short bf16x8 __attribute__((ext_vector_type(8)));
typedef short s16x4 __attribute__((ext_vector_type(4)));
typedef float f32x4 __attribute__((ext_vector_type(4)));
typedef unsigned u32x4 __attribute__((ext_vector_type(4)));
typedef unsigned u32x2 __attribute__((ext_vector_type(2)));
typedef float f32x2 __attribute__((ext_vector_type(2)));
#define LDS_WAIT() asm volatile("s_waitcnt lgkmcnt(0)" ::: "memory")
#define LBAR() do { asm volatile("s_waitcnt lgkmcnt(0)" ::: "memory"); __builtin_amdgcn_s_barrier(); asm volatile("" ::: "memory"); } while (0)
__device__ __forceinline__ float bf2f(bf16_t b) { return __uint_as_float(((unsigned)b) << 16); }
typedef __bf16 bf16x2n __attribute__((ext_vector_type(2)));
typedef float f32x2c __attribute__((ext_vector_type(2)));
__device__ __forceinline__ unsigned pk2(float lo, float hi) { const bf16x2n v = __builtin_convertvector((f32x2c){lo, hi}, bf16x2n); return __builtin_bit_cast(unsigned, v); }
__device__ __forceinline__ unsigned f2bf(float f) { return pk2(f, 0.f) & 0xffffu; }
__device__ __forceinline__ float wave_sum(float v) {
#pragma unroll
    for (int o = 1; o < 64; o <<= 1) v += __shfl_xor(v, o);
    return v;
}
__device__ __forceinline__ bf16x8 rd128(LAS unsigned char* p) { return *(const LAS bf16x8*)p; }
__device__ __forceinline__ bf16x8 trpair(LAS unsigned char* base, int stride, int r0, int r1, int c0, int li) {
    const int q = li >> 2, p = li & 3;
    const s16x4 a = __builtin_amdgcn_ds_read_tr16_b64_v4i16((LAS s16x4*)(base + (r0 + q) * stride + (c0 + 4 * p) * 2));
    const s16x4 b = __builtin_amdgcn_ds_read_tr16_b64_v4i16((LAS s16x4*)(base + (r1 + q) * stride + (c0 + 4 * p) * 2));
    return __builtin_shufflevector(a, b, 0, 1, 2, 3, 4, 5, 6, 7);
}
typedef unsigned u32x2s __attribute__((ext_vector_type(2)));
__device__ __forceinline__ float xg_max(float x) {
    const u32x2s a = __builtin_amdgcn_permlane16_swap(__float_as_uint(x), __float_as_uint(x), false, false);
    const float m = fmaxf(__uint_as_float(a.x), __uint_as_float(a.y));
    const u32x2s b = __builtin_amdgcn_permlane32_swap(__float_as_uint(m), __float_as_uint(m), false, false);
    return fmaxf(__uint_as_float(b.x), __uint_as_float(b.y));
}
__device__ __forceinline__ float xg_sum(float x) {
    const u32x2s a = __builtin_amdgcn_permlane16_swap(__float_as_uint(x), __float_as_uint(x), false, false);
    const float m = __uint_as_float(a.x) + __uint_as_float(a.y);
    const u32x2s b = __builtin_amdgcn_permlane32_swap(__float_as_uint(m), __float_as_uint(m), false, false);
    return __uint_as_float(b.x) + __uint_as_float(b.y);
}
#define MFMA16(A, B, C) __builtin_amdgcn_mfma_f32_16x16x32_bf16((A), (B), (C), 0, 0, 0)

#define XB_TMO      128
#define XB_XCNT(j)  (256  + 64 * (j))
#define XB_XSUB(j)  (1280 + 64 * (j))
#define XB_XGEN(j)  (2304 + 64 * (j))
#define XB_TOP      3328
#define XB_TOPGEN   3392
#define XCD_BAR_WORDS 3456
#define XB_SPIN_CAP (1u << 18)

__device__ __forceinline__ unsigned xb_ld(unsigned* p)              { return __hip_atomic_load(p, __ATOMIC_RELAXED, __HIP_MEMORY_SCOPE_AGENT); }
__device__ __forceinline__ unsigned xb_add(unsigned* p, unsigned v) { return __hip_atomic_fetch_add(p, v, __ATOMIC_RELAXED, __HIP_MEMORY_SCOPE_AGENT); }
__device__ __forceinline__ unsigned xb_xcc_id() { return (unsigned)__builtin_amdgcn_s_getreg((3 << 11) | 20) & 0xFu; }
#define XB_SPIN(cond, bar) do { unsigned _sp = 0; while (cond) { __builtin_amdgcn_s_sleep(1); \
    if ((++_sp & 255u) == 0u) { if (xb_ld(&(bar)[XB_TMO])) break; if (_sp > XB_SPIN_CAP) { atomicAdd(&(bar)[XB_TMO], 1u); break; } } } } while (0)

struct XcdBarrier {
    unsigned* bar; unsigned x;
    volatile LAS unsigned* st;
};

__device__ __forceinline__ XcdBarrier xcd_barrier_post(unsigned* bar, volatile LAS unsigned* st) {
    XcdBarrier b; b.bar = bar; b.x = xb_xcc_id(); b.st = st;
    if (threadIdx.x == 0) (void)xb_add(&bar[XB_XCNT(b.x)], 1u);
    return b;
}
__device__ __forceinline__ void xcd_barrier_complete(unsigned* bar, unsigned x, unsigned& nloc, unsigned& nx) {
    const unsigned G = gridDim.x * gridDim.y * gridDim.z;
    unsigned sum, cnt, mine, sp = 0u;
    for (;;) {
        sum = 0u; cnt = 0u; mine = 0u;
#pragma unroll
        for (unsigned j = 0; j < 16; ++j) { const unsigned c = xb_ld(&bar[XB_XCNT(j)]); sum += c; cnt += (c > 0u) ? 1u : 0u; mine = (j == x) ? c : mine; }
        if (sum == G) break;
        __builtin_amdgcn_s_sleep(1);
        if ((++sp & 255u) == 0u) { if (xb_ld(&bar[XB_TMO])) break; if (sp > XB_SPIN_CAP) { atomicAdd(&bar[XB_TMO], 1u); break; } }
    }
    nloc = mine > 0u ? mine : 1u; nx = cnt > 0u ? cnt : 1u;
}

__device__ __forceinline__ void xcd_barrier(const XcdBarrier& b) {
    asm volatile("s_waitcnt vmcnt(0)" ::: "memory");
    __syncthreads();
    if (threadIdx.x == 0) {
        unsigned* bar = b.bar;
        __builtin_amdgcn_s_waitcnt(0);
        unsigned nloc = b.st[0], nx = b.st[1];
        if (nloc == 0u) { xcd_barrier_complete(bar, b.x, nloc, nx); b.st[0] = nloc; b.st[1] = nx; }
        const unsigned old = xb_add(&bar[XB_XSUB(b.x)], 1u);
        const unsigned gen = old / nloc;
        if (old + 1u == (gen + 1u) * nloc) {
            __builtin_amdgcn_fence(__ATOMIC_RELEASE, "agent");
            asm volatile("s_waitcnt vmcnt(0)" ::: "memory");
            const unsigned og = xb_add(&bar[XB_TOP], 1u);
            const unsigned tg = og / nx;
            if (og + 1u == (tg + 1u) * nx) xb_add(&bar[XB_TOPGEN], 1u);
            else XB_SPIN(xb_ld(&bar[XB_TOPGEN]) == tg, bar);
            __builtin_amdgcn_fence(__ATOMIC_ACQUIRE, "agent");
            xb_add(&bar[XB_XGEN(b.x)], 1u);
            asm volatile("s_waitcnt vmcnt(0)" ::: "memory");
        } else {
            XB_SPIN(xb_ld(&bar[XB_XGEN(b.x)]) == gen, bar);
            __builtin_amdgcn_fence(__ATOMIC_ACQUIRE, "agent");
            asm volatile("s_waitcnt vmcnt(0)" ::: "memory");
        }
    }
    __syncthreads();
}


constexpr size_t MiB = 1u << 20;
constexpr size_t WS_CTL = 0;
constexpr size_t WS_WIN = 1 * MiB;
constexpr size_t WS_WA  = WS_WIN + 192 * MiB;
constexpr size_t WS_WB  = WS_WA + 16 * MiB;
constexpr size_t WS_WO  = WS_WB + 16 * MiB;
constexpr size_t WS_U   = WS_WO + 32 * MiB;
constexpr size_t WS_PROJ = WS_U + 64 * MiB;
constexpr size_t WS_OA  = WS_PROJ + 384 * MiB;
constexpr size_t WS_OB  = WS_OA + 32 * MiB;
constexpr size_t WS_Y   = WS_OB + 32 * MiB;
constexpr size_t WS_W8  = WS_WIN + 128 * MiB;
constexpr size_t WS_U8  = WS_Y + 64 * MiB;
constexpr size_t WS_END = WS_U8 + 32 * MiB;

constexpr int LDS_MISC = 139264;
constexpr int LDS_BYTES = LDS_MISC + 256;
constexpr int NWAVES = 8, NTHR = 512;

struct Args { const float* in[14]; float* out; unsigned char* ws; int ph_lo, ph_hi; };

__device__ __forceinline__ void p0_transpose_item(const float* W, int K, int N, bf16_t* WT, LAS float* scr, int item, int lane) {
    const int nblk = N / 32, kb = item / nblk, nb = item % nblk, k0 = 64 * kb, n0 = 32 * nb;
#pragma unroll 8
    for (int i = 0; i < 32; ++i) { const int kk = 2 * i + (lane >> 5); scr[kk * 33 + (lane & 31)] = __builtin_nontemporal_load(W + (size_t)(k0 + kk) * N + n0 + (lane & 31)); }
    LDS_WAIT();
    const int c = lane & 7;
#pragma unroll
    for (int j = 0; j < 4; ++j) { const int n = (lane >> 3) + 8 * j; const LAS float* s = scr + (8 * c) * 33 + n;
        u32x4 o; o.x = pk2(s[0 * 33], s[1 * 33]); o.y = pk2(s[2 * 33], s[3 * 33]); o.z = pk2(s[4 * 33], s[5 * 33]); o.w = pk2(s[6 * 33], s[7 * 33]);
        *(u32x4*)(WT + (size_t)(n0 + n) * K + k0 + 8 * c) = o; }
    LDS_WAIT();
}
__device__ __forceinline__ unsigned pk4_fp8(float a, float b, float c, float d) { int w = 0; w = __builtin_amdgcn_cvt_pk_fp8_f32(a, b, w, false); w = __builtin_amdgcn_cvt_pk_fp8_f32(c, d, w, true); return (unsigned)w; }
__device__ __forceinline__ void p0_transpose_item_f8(const float* W, unsigned char* WT8, LAS float* scr, int item, int lane) {
    constexpr int K = DM, N = NIN, nblk = 8192 / 32;
    const int kb = item / nblk, nb = item % nblk, k0 = 64 * kb, n0 = 32 * nb;
#pragma unroll 8
    for (int i = 0; i < 32; ++i) { const int kk = 2 * i + (lane >> 5); scr[kk * 33 + (lane & 31)] = __builtin_nontemporal_load(W + (size_t)(k0 + kk) * N + C_GA + n0 + (lane & 31)); }
    LDS_WAIT();
    const int c = lane & 7;
#pragma unroll
    for (int j = 0; j < 4; ++j) { const int n = (lane >> 3) + 8 * j; const LAS float* sp = scr + (8 * c) * 33 + n;
        u32x2 o; o.x = pk4_fp8(sp[0 * 33] * 64.f, sp[1 * 33] * 64.f, sp[2 * 33] * 64.f, sp[3 * 33] * 64.f); o.y = pk4_fp8(sp[4 * 33] * 64.f, sp[5 * 33] * 64.f, sp[6 * 33] * 64.f, sp[7 * 33] * 64.f);
        *(u32x2*)(WT8 + (size_t)(n0 + n) * K + k0 + 8 * c) = o; }
    LDS_WAIT();
}
__device__ __forceinline__ void rms_row(const float* xrow, const float* wv, bf16_t* obf, float* of32, float eps, int lane, unsigned* o8f = nullptr) {
    const f32x4* xr = (const f32x4*)xrow + lane;
    f32x4 v[16]; float s = 0.f;
#pragma unroll
    for (int j = 0; j < 16; ++j) { v[j] = __builtin_nontemporal_load(xr + 64 * j); s += (v[j].x * v[j].x + v[j].y * v[j].y) + (v[j].z * v[j].z + v[j].w * v[j].w); }
    const float rstd = rsqrtf(wave_sum(s) * (1.f / DM) + eps);
    const f32x4* wr = (const f32x4*)wv + lane;
    if (obf) { unsigned long long* o8 = (unsigned long long*)obf + lane;
#pragma unroll
        for (int j = 0; j < 16; ++j) { const f32x4 w4 = wr[64 * j]; const f32x4 y = v[j] * rstd * w4; o8[64 * j] = (unsigned long long)pk2(y.x, y.y) | ((unsigned long long)pk2(y.z, y.w) << 32);
            if (o8f) o8f[lane + 64 * j] = pk4_fp8(y.x, y.y, y.z, y.w); }
    } else { f32x4* o = (f32x4*)of32 + lane;
#pragma unroll
        for (int j = 0; j < 16; ++j) { const f32x4 w4 = wr[64 * j]; o[64 * j] = v[j] * rstd * w4; }
    }
}

__device__ __forceinline__ void rms_row_resid(const float* xrow, const bf16_t* drow, const float* wv, float* orow, float eps, int lane) {
    const f32x4* xr = (const f32x4*)xrow + lane; const u32x2* dr = (const u32x2*)drow + lane;
    f32x4 v[16]; float s = 0.f;
#pragma unroll
    for (int j = 0; j < 16; ++j) { const u32x2 d = __builtin_nontemporal_load(dr + 64 * j); v[j] = __builtin_nontemporal_load(xr + 64 * j) + (f32x4){pg8::bf_lo(d.x), pg8::bf_hi(d.x), pg8::bf_lo(d.y), pg8::bf_hi(d.y)};
        s += (v[j].x * v[j].x + v[j].y * v[j].y) + (v[j].z * v[j].z + v[j].w * v[j].w); }
    const float rstd = rsqrtf(wave_sum(s) * (1.f / DM) + eps);
    const f32x4* wr = (const f32x4*)wv + lane; f32x4* o = (f32x4*)orow + lane;
#pragma unroll
    for (int j = 0; j < 16; ++j) { const f32x4 w4 = wr[64 * j]; o[64 * j] = v[j] * rstd * w4; }
}

constexpr int HS = 272, SCS = 144;
constexpr int H_QD = 0, H_KI = 17408, H_KE = 34816, H_VV = 52224, H_ST = 69632, H_SC = 104448, H_DEC = 113664, H_PS = 114176, H_RS = 118272;
__device__ __forceinline__ void hgrn_item(LAS unsigned char* lds, const bf16_t* PROJ, bf16_t* OA, const float* lbt, const float* hnw, int item) {
    const int tid = threadIdx.x, lane = tid & 63, w = __builtin_amdgcn_readfirstlane(tid >> 6), g = lane >> 4, li = lane & 15;
    const int b = item >> 4, h = item & 15;
    const bf16_t* P = PROJ + (size_t)(b * SEQ) * NIN;
    const int kp = tid & 63, part = w;
    float lb[2], oml[2];
#pragma unroll
    for (int e = 0; e < 2; ++e) { const float t0 = lbt[h * 128 + 2 * kp + e], t1 = lbt[2048 + h * 128 + 2 * kp + e]; lb[e] = 1.f / (1.f + __expf(t1 - t0)); oml[e] = 1.f - lb[e]; }
    LAS float* DEC = (LAS float*)(lds + H_DEC); LAS float* PS = (LAS float*)(lds + H_PS); LAS float* RS = (LAS float*)(lds + H_RS);
    for (int i = tid; i < 34816 / 16; i += NTHR) *(LAS u32x4*)(lds + H_ST + i * 16) = (u32x4){0u, 0u, 0u, 0u};
    f32x4 st[8];
#pragma unroll
    for (int i = 0; i < 8; ++i) st[i] = (f32x4){0.f, 0.f, 0.f, 0.f};
    unsigned zr[8], qr[8], vr[8];
    { const bf16_t* p0 = P + (size_t)(part * 8) * NIN + h * 128 + 2 * kp;
#pragma unroll
      for (int i = 0; i < 8; ++i) { zr[i] = __builtin_nontemporal_load((const unsigned*)(p0 + (size_t)i * NIN + C_AF)); qr[i] = __builtin_nontemporal_load((const unsigned*)(p0 + (size_t)i * NIN + C_AQ)); vr[i] = __builtin_nontemporal_load((const unsigned*)(p0 + (size_t)i * NIN + C_AI)); } }
    const int ct = w & 3, vb = 4 * (w >> 2);
    for (int n = 0; n < SEQ / 64; ++n) {
        float lf[8][2], kg[8][2];
        float run[2] = {1.f, 1.f};
#pragma unroll
        for (int i = 0; i < 8; ++i)
#pragma unroll
            for (int e = 0; e < 2; ++e) {
                const float z = e ? pg8::bf_hi(zr[i]) : pg8::bf_lo(zr[i]); const float ex = __expf(-fabsf(z)), r = __builtin_amdgcn_rcpf(1.f + ex), sp = r, sn = ex * r;
                const float sg = z >= 0.f ? sp : sn, sgm = z >= 0.f ? sn : sp;
                run[e] *= (lb[e] + oml[e] * sg); lf[i][e] = run[e]; kg[i][e] = oml[e] * sgm;
            }
        *(LAS f32x2*)(PS + part * 128 + 2 * kp) = (f32x2){run[0], run[1]};
        LBAR();
        float off[2] = {1.f, 1.f}, bl[2] = {1.f, 1.f};
#pragma unroll
        for (int p = 0; p < 8; ++p) { const f32x2 t = *(const LAS f32x2*)(PS + p * 128 + 2 * kp); bl[0] *= t.x; bl[1] *= t.y; off[0] *= (p < part) ? t.x : 1.f; off[1] *= (p < part) ? t.y : 1.f; }
#pragma unroll
        for (int i = 0; i < 8; ++i) { const int r = part * 8 + i;
            const float eb0 = off[0] * lf[i][0], eb1 = off[1] * lf[i][1], ki0 = kg[i][0] * __builtin_amdgcn_rcpf(eb0), ki1 = kg[i][1] * __builtin_amdgcn_rcpf(eb1);
            *(LAS unsigned*)(lds + H_QD + r * HS + kp * 4) = pk2(pg8::bf_lo(qr[i]) * eb0, pg8::bf_hi(qr[i]) * eb1);
            *(LAS unsigned*)(lds + H_KI + r * HS + kp * 4) = pk2(ki0, ki1);
            *(LAS unsigned*)(lds + H_VV + r * HS + kp * 4) = vr[i]; }
        if (part == 0) *(LAS f32x2*)(DEC + 2 * kp) = (f32x2){bl[0], bl[1]};
        if (n + 1 < SEQ / 64) { const bf16_t* p0 = P + (size_t)((n + 1) * 64 + part * 8) * NIN + h * 128 + 2 * kp;
#pragma unroll
            for (int i = 0; i < 8; ++i) { zr[i] = __builtin_nontemporal_load((const unsigned*)(p0 + (size_t)i * NIN + C_AF)); qr[i] = __builtin_nontemporal_load((const unsigned*)(p0 + (size_t)i * NIN + C_AQ)); vr[i] = __builtin_nontemporal_load((const unsigned*)(p0 + (size_t)i * NIN + C_AI)); } }
        u32x2 gr[4];
#pragma unroll
        for (int u = 0; u < 4; ++u) gr[u] = __builtin_nontemporal_load((const u32x2*)(P + (size_t)(n * 64 + 16 * ct + li) * NIN + C_AG + h * 128 + 16 * (vb + u) + 4 * g));
        LBAR();
        bf16x8 QDf[4];
#pragma unroll
        for (int ks = 0; ks < 4; ++ks) QDf[ks] = rd128(lds + H_QD + (16 * ct + li) * HS + (32 * ks + 8 * g) * 2);
        bf16x8 Pf[2];
#pragma unroll
        for (int a2 = 0; a2 < 2; ++a2) { f32x4 sa[2];
#pragma unroll
            for (int t = 0; t < 2; ++t) { const int stl = 2 * a2 + t; sa[t] = (f32x4){0.f, 0.f, 0.f, 0.f};
                if (stl <= ct) {
#pragma unroll
                    for (int ks = 0; ks < 4; ++ks) sa[t] = MFMA16(rd128(lds + H_KI + (16 * stl + li) * HS + (32 * ks + 8 * g) * 2), QDf[ks], sa[t]);
                    if (stl == ct) {
#pragma unroll
                        for (int j = 0; j < 4; ++j) sa[t][j] = (4 * g + j <= li) ? sa[t][j] : 0.f; } } }
            u32x4 tt; tt.x = pk2(sa[0][0], sa[0][1]); tt.y = pk2(sa[0][2], sa[0][3]); tt.z = pk2(sa[1][0], sa[1][1]); tt.w = pk2(sa[1][2], sa[1][3]);
            Pf[a2] = __builtin_bit_cast(bf16x8, tt); }
        f32x4 oacc[4];
#pragma unroll
        for (int u = 0; u < 4; ++u) oacc[u] = (f32x4){0.f, 0.f, 0.f, 0.f};
#pragma unroll
        for (int a2 = 0; a2 < 2; ++a2)
            if (2 * a2 <= ct) {
#pragma unroll
                for (int u = 0; u < 4; ++u) oacc[u] = MFMA16(trpair(lds + H_VV, HS, 32 * a2 + 4 * g, 32 * a2 + 16 + 4 * g, 16 * (vb + u), li), Pf[a2], oacc[u]); }
#pragma unroll
        for (int ks = 0; ks < 4; ++ks)
#pragma unroll
            for (int u = 0; u < 4; ++u) oacc[u] = MFMA16(rd128(lds + H_ST + (16 * (vb + u) + li) * HS + (32 * ks + 8 * g) * 2), QDf[ks], oacc[u]);
        { float sq = 0.f;
#pragma unroll
          for (int u = 0; u < 4; ++u) sq += (oacc[u][0] * oacc[u][0] + oacc[u][1] * oacc[u][1]) + (oacc[u][2] * oacc[u][2] + oacc[u][3] * oacc[u][3]);
          sq = xg_sum(sq);
          if (g == 0) RS[(w >> 2) * 64 + 16 * ct + li] = sq; }
        { bf16x8 Af[2];
#pragma unroll
          for (int ks2 = 0; ks2 < 2; ++ks2) Af[ks2] = trpair(lds + H_KI, HS, 32 * ks2 + 8 * g, 32 * ks2 + 8 * g + 4, 16 * w, li);
          float dc[4];
#pragma unroll
          for (int j = 0; j < 4; ++j) dc[j] = DEC[16 * w + 4 * g + j];
#pragma unroll
          for (int vt = 0; vt < 8; ++vt) {
#pragma unroll
              for (int ks2 = 0; ks2 < 2; ++ks2) st[vt] = MFMA16(Af[ks2], trpair(lds + H_VV, HS, 32 * ks2 + 8 * g, 32 * ks2 + 8 * g + 4, 16 * vt, li), st[vt]);
#pragma unroll
              for (int j = 0; j < 4; ++j) st[vt][j] *= dc[j]; } }
        LBAR();
#pragma unroll
        for (int vt = 0; vt < 8; ++vt) *(LAS u32x2*)(lds + H_ST + (16 * vt + li) * HS + (16 * w + 4 * g) * 2) = (u32x2){pk2(st[vt][0], st[vt][1]), pk2(st[vt][2], st[vt][3])};
        { const int c = 16 * ct + li; const float tot = RS[c] + RS[64 + c]; const float rstd = rsqrtf(tot * (1.f / 128.f) + 1e-6f);
          bf16_t* orow = OA + ((size_t)(b * SEQ) + (size_t)(n * 64 + c)) * AW + h * 128 + 4 * g;
#pragma unroll
          for (int u = 0; u < 4; ++u) { const f32x4 hw4 = *(const f32x4*)(hnw + 16 * (vb + u) + 4 * g);
              const float g0 = pg8::bf_lo(gr[u].x), g1 = pg8::bf_hi(gr[u].x), g2 = pg8::bf_lo(gr[u].y), g3 = pg8::bf_hi(gr[u].y);
              const float y0 = oacc[u][0] * rstd * hw4.x * g0 * __builtin_amdgcn_rcpf(1.f + __expf(-g0)), y1 = oacc[u][1] * rstd * hw4.y * g1 * __builtin_amdgcn_rcpf(1.f + __expf(-g1));
              const float y2 = oacc[u][2] * rstd * hw4.z * g2 * __builtin_amdgcn_rcpf(1.f + __expf(-g2)), y3 = oacc[u][3] * rstd * hw4.w * g3 * __builtin_amdgcn_rcpf(1.f + __expf(-g3));
              *(u32x2*)(orow + 16 * (vb + u)) = (u32x2){pk2(y0, y1), pk2(y2, y3)}; } }
    }
}

constexpr int KS_ = 272, VS_ = 544;
constexpr int A_K0 = 0, A_K1 = 8704, A_V = 17408, A_BUF = 34816, A_Q0 = 69632, A_Q1 = 104448;
__device__ __forceinline__ void attn_item(LAS unsigned char* lds, const bf16_t* PROJ, bf16_t* OB, const float* subw, float lam, int idx) {
    const int tid = threadIdx.x, lane = tid & 63, w = __builtin_amdgcn_readfirstlane(tid >> 6), g = lane >> 4, li = lane & 15;
    const int qb = 15 - (idx >> 5), bh = idx & 31, b = bh >> 3, h = bh & 7;
    const int q0 = qb * 128 + 16 * w, qpos = q0 + li;
    const bf16_t* P = PROJ + (size_t)(b * SEQ) * NIN;
    const float LOG2E = 1.4426950408889634f;
    const float slope2 = __builtin_amdgcn_exp2f(-(float)(h + 1)) * LOG2E, c1 = 0.08838834764831845f * LOG2E;
    f32x4 o[2][16];
#pragma unroll
    for (int m = 0; m < 2; ++m)
#pragma unroll
        for (int i = 0; i < 16; ++i) o[m][i] = (f32x4){0.f, 0.f, 0.f, 0.f};
    float mrun[2] = {-1e30f, -1e30f}, lrun[2] = {0.f, 0.f};
    u32x4 pf[4];
    const unsigned voK = (unsigned)(((tid >> 4) * NIN + C_BK + h * 256 + (tid & 15) * 8) * 2), voV = (unsigned)(((tid >> 5) * NIN + C_BV + h * 256 + (tid & 31) * 8) * 2);
    const unsigned loK = (unsigned)((tid >> 4) * KS_ + (tid & 15) * 16), loV = (unsigned)((tid >> 5) * VS_ + (tid & 31) * 16);
    const char* Pb = (const char*)P;
#define ATT_PREFETCH(kt) do { const char* pk_ = Pb + (size_t)(kt) * (32 * NIN * 2); \
        pf[0] = *(const u32x4*)(pk_ + voK); pf[1] = *(const u32x4*)(pk_ + 256 + voK); \
        pf[2] = *(const u32x4*)(pk_ + voV); pf[3] = *(const u32x4*)(pk_ + (size_t)(16 * NIN * 2) + voV); } while (0)
#define ATT_WRITE(bo) do { *(LAS u32x4*)(lds + (bo) + A_K0 + loK) = pf[0]; *(LAS u32x4*)(lds + (bo) + A_K1 + loK) = pf[1]; \
        *(LAS u32x4*)(lds + (bo) + A_V + loV) = pf[2]; *(LAS u32x4*)(lds + (bo) + A_V + 16 * VS_ + loV) = pf[3]; } while (0)
    LBAR();
    { const bf16_t* pq = P + (size_t)(qb * 128) * NIN + C_BQ + h * 256;
#pragma unroll
      for (int hh = 0; hh < 2; ++hh) {
#pragma unroll
        for (int i = 0; i < 4; ++i) { const int c = tid + 512 * (4 * hh + i), r = c >> 5, c16 = c & 31; pf[i] = *(const u32x4*)(pq + (size_t)r * NIN + c16 * 8); }
#pragma unroll
        for (int i = 0; i < 4; ++i) { const int c = tid + 512 * (4 * hh + i), r = c >> 5, c16 = c & 31; *(LAS u32x4*)(lds + ((c16 & 16) ? A_Q1 : A_Q0) + r * KS_ + (c16 & 15) * 16) = pf[i]; } } }
    const int nkt = 4 * qb + 4;
    ATT_PREFETCH(0);
    ATT_WRITE(0);
    ATT_PREFETCH(1);
    LBAR();
    LAS unsigned char* Qw = lds + A_Q0 + (16 * w + li) * KS_ + 16 * g;
    for (int kt = 0; kt < nkt; ++kt) {
        const int bo = (kt & 1) * A_BUF;
        if (32 * kt <= q0 + 15) {
            bf16x8 Pf[2]; float alpha[2];
            const int rel = qpos - 32 * kt - 4 * g;
            const float bias0 = -slope2 * (float)rel;
            const bool diag = (32 * kt + 31 > q0);
#pragma unroll
            for (int m = 0; m < 2; ++m) {
                f32x4 s[2];
                s[0] = (f32x4){0.f, 0.f, 0.f, 0.f}; s[1] = (f32x4){0.f, 0.f, 0.f, 0.f};
#pragma unroll
                for (int ks = 0; ks < 4; ++ks) { const bf16x8 qf = rd128(Qw + m * (A_Q1 - A_Q0) + 64 * ks);
#pragma unroll
                    for (int t4 = 0; t4 < 2; ++t4) s[t4] = MFMA16(rd128(lds + bo + (m ? A_K1 : A_K0) + (16 * t4 + li) * KS_ + (32 * ks + 8 * g) * 2), qf, s[t4]); }
                float mx = -1e30f;
#pragma unroll
                for (int t4 = 0; t4 < 2; ++t4)
#pragma unroll
                    for (int j = 0; j < 4; ++j) { float v = fmaf(s[t4][j], c1, bias0) + slope2 * (float)(16 * t4 + j); if (diag) v = ((16 * t4 + j) > rel) ? -1e30f : v; s[t4][j] = v; mx = fmaxf(mx, v); }
                mx = xg_max(mx);
                const float mnew = fmaxf(mrun[m], mx); alpha[m] = __builtin_amdgcn_exp2f(mrun[m] - mnew); mrun[m] = mnew;
                float psum = 0.f;
#pragma unroll
                for (int t4 = 0; t4 < 2; ++t4)
#pragma unroll
                    for (int j = 0; j < 4; ++j) { const float p = __builtin_amdgcn_exp2f(s[t4][j] - mnew); s[t4][j] = p; psum += p; }
                lrun[m] = lrun[m] * alpha[m] + psum;
                u32x4 t; t.x = pk2(s[0][0], s[0][1]); t.y = pk2(s[0][2], s[0][3]); t.z = pk2(s[1][0], s[1][1]); t.w = pk2(s[1][2], s[1][3]);
                Pf[m] = __builtin_bit_cast(bf16x8, t);
            }
            if (__builtin_amdgcn_ballot_w64(alpha[0] != 1.0f || alpha[1] != 1.0f) != 0ull) {
#pragma unroll
                for (int vt = 0; vt < 16; ++vt) { o[0][vt] = o[0][vt] * alpha[0]; o[1][vt] = o[1][vt] * alpha[1]; }
            }
#pragma unroll
            for (int vt = 0; vt < 16; ++vt) { const bf16x8 vf = trpair(lds + bo + A_V, VS_, 4 * g, 16 + 4 * g, 16 * vt, li);
                o[0][vt] = MFMA16(vf, Pf[0], o[0][vt]); o[1][vt] = MFMA16(vf, Pf[1], o[1][vt]); }
        }
        if (kt + 1 < nkt) { ATT_WRITE(A_BUF - bo); if (kt + 2 < nkt) ATT_PREFETCH(kt + 2); }
        LBAR();
    }
#undef ATT_PREFETCH
#undef ATT_WRITE
    float inv[2];
#pragma unroll
    for (int m = 0; m < 2; ++m) inv[m] = 1.f / xg_sum(lrun[m]);
    const float i0 = inv[0], i1 = inv[1] * lam;
    float ss = 0.f;
#pragma unroll
    for (int vt = 0; vt < 16; ++vt) { const f32x4 d = o[0][vt] * i0 - o[1][vt] * i1; o[0][vt] = d; ss += (d.x * d.x + d.y * d.y) + (d.z * d.z + d.w * d.w); }
    ss = xg_sum(ss);
    const float rstd = rsqrtf(ss * (1.f / 256.f) + 1e-5f) * 0.8f;
    const size_t tok = (size_t)(b * SEQ + qpos);
#pragma unroll
    for (int vt = 0; vt < 16; ++vt) { const int v0 = 16 * vt + 4 * g;
        const u32x2 gw = *(const u32x2*)(PROJ + tok * NIN + C_BG + h * 256 + v0); const f32x4 sw = *(const f32x4*)(subw + v0);
        const float g0 = pg8::bf_lo(gw.x), g1 = pg8::bf_hi(gw.x), g2 = pg8::bf_lo(gw.y), g3 = pg8::bf_hi(gw.y);
        const float y0 = o[0][vt].x * rstd * sw.x * g0 * __builtin_amdgcn_rcpf(1.f + __expf(-g0)), y1 = o[0][vt].y * rstd * sw.y * g1 * __builtin_amdgcn_rcpf(1.f + __expf(-g1));
        const float y2 = o[0][vt].z * rstd * sw.z * g2 * __builtin_amdgcn_rcpf(1.f + __expf(-g2)), y3 = o[0][vt].w * rstd * sw.w * g3 * __builtin_amdgcn_rcpf(1.f + __expf(-g3));
        *(u32x2*)(OB + tok * AW + h * 256 + v0) = (u32x2){pk2(y0, y1), pk2(y2, y3)}; }
}

constexpr int N_HGRN = 64, N_ATT = 512, N_ITEMS = N_HGRN + N_ATT;
__global__ void __launch_bounds__(NTHR, 2) mega_fwd(Args a) {
    extern __shared__ __attribute__((aligned(16))) unsigned char lds_raw[];
    LAS unsigned char* lds = (LAS unsigned char*)lds_raw;
    cg::grid_group grid = cg::this_grid();
    const int tid = threadIdx.x, lane = tid & 63, wave = __builtin_amdgcn_readfirstlane(tid >> 6);
    const int G = gridDim.x;
    unsigned char* ws = a.ws;
    unsigned* ctl = (unsigned*)(ws + WS_CTL);
    bf16_t* WIN = (bf16_t*)(ws + WS_WIN); bf16_t* WA = (bf16_t*)(ws + WS_WA); bf16_t* WB = (bf16_t*)(ws + WS_WB); bf16_t* WO = (bf16_t*)(ws + WS_WO);
    bf16_t* U = (bf16_t*)(ws + WS_U); bf16_t* PROJ = (bf16_t*)(ws + WS_PROJ); bf16_t* OA = (bf16_t*)(ws + WS_OA); bf16_t* OB = (bf16_t*)(ws + WS_OB); bf16_t* Y = (bf16_t*)(ws + WS_Y); unsigned char* W8 = ws + WS_W8; unsigned char* U8 = ws + WS_U8;
    const float* x = a.in[0]; const float* norm_w = a.in[1]; const float* w_in = a.in[2]; const float* lbt = a.in[3]; const float* hnw = a.in[4];
    const float* lq1 = a.in[5]; const float* lk1 = a.in[6]; const float* lq2 = a.in[7]; const float* lk2 = a.in[8]; const float* subw = a.in[9];
    const float* w_a = a.in[10]; const float* w_b = a.in[11]; const float* w_o = a.in[12]; const float* final_w = a.in[13];
    const int lo = a.ph_lo, hi = a.ph_hi;
    volatile LAS unsigned* MISCU = (volatile LAS unsigned*)(lds + LDS_MISC);
    if (tid == 0) { MISCU[8] = 0u; MISCU[9] = 0u; }
    __syncthreads();
    XcdBarrier xb = xcd_barrier_post(ctl + 1024, MISCU + 8);
#define IN(k) (lo <= (k) && (k) < hi)
#define SEAM(k) do { if (IN(k) && IN((k) + 1)) xcd_barrier(xb); } while (0)
    if (hi == 777) grid.sync();

    if (IN(0)) {
        if (blockIdx.x == 0 && tid == 0) { __hip_atomic_store(ctl, 0u, __ATOMIC_RELAXED, __HIP_MEMORY_SCOPE_AGENT); __hip_atomic_store(ctl + 64, 0u, __ATOMIC_RELAXED, __HIP_MEMORY_SCOPE_AGENT); __hip_atomic_store(ctl + 128, 0u, __ATOMIC_RELAXED, __HIP_MEMORY_SCOPE_AGENT); }
        LAS float* scr = (LAS float*)(lds + wave * 16384);
        const int gw = blockIdx.x * NWAVES + wave, NGW = G * NWAVES;
        constexpr int I_IN = (DM / 64) * (NIN / 32);
        for (int it = gw; it < 64 * 512; it += NGW) p0_transpose_item(w_in, DM, NIN, WIN, scr, (it >> 9) * (NIN / 32) + (it & 511), lane);
        for (int it = gw; it < 64 * 256; it += NGW) p0_transpose_item_f8(w_in, W8, scr, it, lane);
        for (int mr_ = gw; mr_ < MT * (PROBE_PH == 0 ? 2 : 1); mr_ += NGW) { const int mrow = mr_ % MT; rms_row(x + (size_t)mrow * DM, norm_w, U + (size_t)mrow * DM, nullptr, 1e-6f, lane, (unsigned*)(U8 + (size_t)mrow * DM)); }
    }
    SEAM(0);
    if (IN(1)) {
        { pg8::Gemm g{U, WIN, U, WIN, DM}; pg8::StaticOrder S; S.init(MT, C_GA, G, (int)blockIdx.x);
          pg8::EpiProj E{PROJ, NIN, 0, 1.0f, 0};
          pg8::gemm_phase<pg8::EpiProj, pg8::StaticOrder, true, true, false>(lds, g, S, E); }
        { pg8::Gemm g{(const bf16_t*)U8, (const bf16_t*)W8, (const bf16_t*)U8, (const bf16_t*)W8, DM / 2}; pg8::StaticOrder S; S.init(MT, NIN - C_GA, G, (int)blockIdx.x);
          pg8::EpiProj E{PROJ, NIN, C_GA, 1.0f / 64.0f, 1};
          pg8::gemm_phase<pg8::EpiProj, pg8::StaticOrder, true, true, true>(lds, g, S, E); }
    }
    SEAM(1);
    if (IN(2)) {
        float lam;
        { const float p1 = lq1[lane] * lk1[lane] + lq1[lane + 64] * lk1[lane + 64], p2 = lq2[lane] * lk2[lane] + lq2[lane + 64] * lk2[lane + 64];
          lam = __expf(wave_sum(p1)) - __expf(wave_sum(p2)) + 0.2f; }
        volatile LAS int* MISC = (volatile LAS int*)(lds + LDS_MISC);
        for (;;) {
            LBAR();
            if (tid == 0) MISC[0] = (int)__hip_atomic_fetch_add(ctl, 1u, __ATOMIC_RELAXED, __HIP_MEMORY_SCOPE_AGENT);
            LBAR();
            const int item = MISC[0];
            if (item >= N_HGRN * (PROBE_PH == 2 ? 2 : 1)) break;
            hgrn_item(lds, PROJ, OA, lbt, hnw, item % N_HGRN);
        }
        for (;;) {
            LBAR();
            if (tid == 0) MISC[0] = (int)__hip_atomic_fetch_add(ctl + 64, 1u, __ATOMIC_RELAXED, __HIP_MEMORY_SCOPE_AGENT);
            LBAR();
            const int item = MISC[0];
            if (item >= N_ATT * (PROBE_PH == 2 ? 2 : 1)) break;
            attn_item(lds, PROJ, OB, subw, lam, item % N_ATT);
        }
        { constexpr int I_A = (AW / 64) * (DM / 32), I_O = (DM / 64) * (DM / 32);
          LAS float* scr = (LAS float*)(lds + wave * 16384);
          for (;;) {
            LBAR();
            if (tid == 0) MISC[0] = (int)__hip_atomic_fetch_add(ctl + 128, 1u, __ATOMIC_RELAXED, __HIP_MEMORY_SCOPE_AGENT);
            LBAR();
            const int item = MISC[0];
            if (item >= (2 * I_A + I_O) / NWAVES) break;
            int r = item * NWAVES + wave;
            if (r < I_A) { p0_transpose_item(w_a, AW, DM, WA, scr, r, lane); continue; } r -= I_A;
            if (r < I_A) { p0_transpose_item(w_b, AW, DM, WB, scr, r, lane); continue; } r -= I_A;
            p0_transpose_item(w_o, DM, DM, WO, scr, r, lane);
          } }
    }
    SEAM(2);
    if (IN(3)) {
        pg8::Gemm g{OA, WA, OB, WB, AW}; pg8::ChainOrder S; S.init(MT, DM, G, (int)blockIdx.x, PROBE_PH == 3 ? 2 : 1);
        pg8::EpiMerge E{PROJ, Y};
        pg8::gemm_phase<pg8::EpiMerge, pg8::ChainOrder, true, true>(lds, g, S, E);
    }
    SEAM(3);
    if (IN(4)) {
        pg8::Gemm g{Y, WO, Y, WO, DM}; pg8::StaticOrder S; S.init(MT, DM, G, (int)blockIdx.x, PROBE_PH == 4 ? 2 : 1);
        pg8::EpiProj E{U, DM, 0, 1.0f, 0};
        pg8::gemm_phase<pg8::EpiProj, pg8::StaticOrder, true, true>(lds, g, S, E);
    }
    SEAM(4);
    if (IN(5)) {
        const int gw = blockIdx.x * NWAVES + wave, NGW = G * NWAVES;
        for (int mrow = gw; mrow < MT; mrow += NGW) rms_row_resid(x + (size_t)mrow * DM, U + (size_t)mrow * DM, final_w, a.out + (size_t)mrow * DM, 1e-6f, lane);
    }
}

extern "C" void kernel_launch(void* const* d_in, const int* in_sizes, int n_in, void* d_out, int out_size, void* d_ws, size_t ws_size, hipStream_t stream) {
    static int grid = 0;
    if (!grid) {
        if (n_in != 14 || out_size != MT * DM || ws_size < WS_END) { fprintf(stderr, "kernel_launch: unexpected shapes (n_in %d, out %d, ws %zu)\n", n_in, out_size, ws_size); return; }
        int dev = 0, cus = 0, per_cu = 0;
        hipGetDevice(&dev); hipDeviceGetAttribute(&cus, hipDeviceAttributeMultiprocessorCount, dev);
        hipFuncSetAttribute((const void*)mega_fwd, hipFuncAttributeMaxDynamicSharedMemorySize, LDS_BYTES);
        hipOccupancyMaxActiveBlocksPerMultiprocessor(&per_cu, (const void*)mega_fwd, NTHR, LDS_BYTES);
        if (per_cu < 1) { fprintf(stderr, "kernel_launch: occupancy query says %d blocks per CU\n", per_cu); per_cu = 1; }
        grid = cus * per_cu;
        if (grid % 8 != 0 || grid <= 0) { fprintf(stderr, "kernel_launch: odd grid %d\n", grid); }
    }
    if (hipMemsetAsync(d_ws, 0, 32768, stream) != hipSuccess) { fprintf(stderr, "kernel_launch: memset of the control words failed\n"); return; }
    Args a{};
    for (int i = 0; i < 14; ++i) a.in[i] = (const float*)d_in[i];
    a.out = (float*)d_out; a.ws = (unsigned char*)d_ws;
#if MK_N_LAUNCHES == 1
    a.ph_lo = 0; a.ph_hi = 6;
    void* args[] = {&a};
    hipError_t e = hipLaunchCooperativeKernel((const void*)mega_fwd, dim3(grid), dim3(NTHR), args, LDS_BYTES, stream);
    if (e != hipSuccess) fprintf(stderr, "cooperative launch failed: %s (grid %d)\n", hipGetErrorString(e), grid);
#else
    for (int ph = 0; ph < 6; ++ph) { a.ph_lo = ph; a.ph_hi = ph + 1; hipLaunchKernelGGL(mega_fwd, dim3(grid), dim3(NTHR), LDS_BYTES, stream, a); }
#endif
}
```

```cpp
#include <hip/hip_runtime.h>
#include <hip/hip_cooperative_groups.h>
#include <cstdio>
#include <cstdint>
namespace cg = cooperative_groups;

#ifndef MK_N_LAUNCHES
#define MK_N_LAUNCHES 1
#endif
#ifndef PROBE_PH
#define PROBE_PH -1
#endif

constexpr int DM = 4096, BATCH = 4, SEQ = 2048, MT = BATCH * SEQ, NIN = 24576;
constexpr int C_AQ = 0, C_AF = 2048, C_AI = 4096, C_AG = 6144, C_BQ = 8192, C_BK = 10240, C_BV = 12288, C_BG = 14336, C_GA = 16384, C_GB = 20480;
constexpr int AW = 2048;

namespace pg8 {
#define PG8_LAS __attribute__((address_space(3)))
typedef unsigned short bf16_t;
typedef short bf16x8 __attribute__((ext_vector_type(8)));
typedef float f32x4 __attribute__((ext_vector_type(4)));
typedef unsigned u32x4 __attribute__((ext_vector_type(4)));
constexpr int BM = 256, BK = 64, HALF = 128, HTB = HALF * BK * 2  , STAGE_BYTES = 8 * HTB, NXCD = 8, WGM = 8;

__host__ __device__ __forceinline__ int lds_byte(int r, int c) { const int st = (r >> 4) * 2 + (c >> 5), rr = r & 15, cc = c & 31, ob = rr * 64 + cc * 2; return st * 1024 + (ob ^ (((ob >> 9) & 1) << 5)); }
__host__ __device__ __forceinline__ void stage_rc(int b, int& R, int& C) { const int st = b / 1024, sb = b % 1024, swz = sb ^ (((sb >> 9) & 1) << 5); R = (st >> 1) * 16 + swz / 64; C = (st & 1) * 32 + (swz % 64) / 2; }
__host__ __device__ __forceinline__ int perm32(int rho) { const int n = rho >> 4, i = rho & 15; return 8 * (i >> 2) + 4 * n + (i & 3); }

struct Unit { int pm, pn, half; };
struct Gemm { const bf16_t* A; const bf16_t* Bt; const bf16_t* A2; const bf16_t* Bt2; int K; };

struct StaticOrder {
    int nM, nN, nwg, G, c, rep;
    __host__ __device__ void init(int M, int N, int G_, int c_, int rep_ = 1) { nM = M / BM; nN = N / BM; nwg = nM * nN; G = G_; c = c_; rep = rep_; }
    __host__ __device__ bool next(int i, Unit& u) const {
        u.half = 0;
        const int R = (nwg + G - 1) / G; if (i >= R * rep) return false; i = i % R;
        const long L = (long)i * G + c; if (L >= nwg) return false;
        int wgid = (int)L; { const int q = nwg / NXCD, r = nwg % NXCD, xcd = wgid % NXCD, off = wgid / NXCD; wgid = (xcd < r ? xcd * (q + 1) : r * (q + 1) + (xcd - r) * q) + off; }
        const int nig = WGM * nN, gid = wgid / nig, fm = gid * WGM, gsz = (nM - fm) < WGM ? (nM - fm) : WGM;
        u.pm = fm + ((wgid % nig) % gsz); u.pn = (wgid % nig) / gsz; return true;
    }
};
struct ChainOrder : StaticOrder {
    __host__ __device__ bool next(int i, Unit& u) const { const bool ok = StaticOrder::next(i >> 1, u); u.half = i & 1; return ok; }
};

typedef __bf16 bf16x2h __attribute__((ext_vector_type(2)));
typedef float f32x2h __attribute__((ext_vector_type(2)));
__device__ __forceinline__ unsigned cvt_pk_bf16(float lo, float hi) { const bf16x2h v = __builtin_convertvector((f32x2h){lo, hi}, bf16x2h); return __builtin_bit_cast(unsigned, v); }
__device__ __forceinline__ float bf_lo(unsigned w) { return __uint_as_float(w << 16); }
__device__ __forceinline__ float bf_hi(unsigned w) { return __uint_as_float(w & 0xffff0000u); }

struct EpiProj {
    static constexpr bool PERM = true;
    bf16_t* O; int ldc; int col_off; float scale; int sig;
    __device__ __forceinline__ bool operator()(f32x4 (&acc)[2][2][4][2], const Unit& u, int wr, int wc, int fr, int fq) const {
        const int row0 = u.pm * BM + wr * 64 + fr, col0 = col_off + u.pn * BM + wc * 32 + 8 * fq;
#pragma unroll
        for (int ai = 0; ai < 2; ++ai)
#pragma unroll
            for (int m = 0; m < 4; ++m) { bf16_t* rowp = O + (size_t)(row0 + ai * HALF + m * 16) * ldc + col0;
#pragma unroll
                for (int bj = 0; bj < 2; ++bj) { f32x4 v0 = acc[ai][bj][m][0] * scale, v1 = acc[ai][bj][m][1] * scale;
                    if (sig) {
#pragma unroll
                        for (int j = 0; j < 4; ++j) { v0[j] = __builtin_amdgcn_rcpf(1.f + __expf(-v0[j])); v1[j] = __builtin_amdgcn_rcpf(1.f + __expf(-v1[j])); } }
                    u32x4 w; w.x = cvt_pk_bf16(v0[0], v0[1]); w.y = cvt_pk_bf16(v0[2], v0[3]); w.z = cvt_pk_bf16(v1[0], v1[1]); w.w = cvt_pk_bf16(v1[2], v1[3]);
                    *(u32x4*)(rowp + bj * HALF) = w; } }
        return false;
    }
};
struct EpiMerge {
    static constexpr bool PERM = true;
    const bf16_t* P; bf16_t* Y;
    __device__ __forceinline__ bool operator()(f32x4 (&acc)[2][2][4][2], const Unit& u, int wr, int wc, int fr, int fq) const {
        const int row0 = u.pm * BM + wr * 64 + fr, col0 = u.pn * BM + wc * 32 + 8 * fq;
#pragma unroll
        for (int ai = 0; ai < 2; ++ai)
#pragma unroll
            for (int m = 0; m < 4; ++m) { const size_t r = (size_t)(row0 + ai * HALF + m * 16);
#pragma unroll
                for (int bj = 0; bj < 2; ++bj) { const int c = col0 + bj * HALF;
                    const u32x4 gb = *(const u32x4*)(P + r * NIN + C_GB + c);
                    float sb[8]; sb[0] = bf_lo(gb.x); sb[1] = bf_hi(gb.x); sb[2] = bf_lo(gb.y); sb[3] = bf_hi(gb.y); sb[4] = bf_lo(gb.z); sb[5] = bf_hi(gb.z); sb[6] = bf_lo(gb.w); sb[7] = bf_hi(gb.w);
                    if (u.half == 0) {
                        const u32x4 ga = *(const u32x4*)(P + r * NIN + C_GA + c);
                        float sa[8]; sa[0] = bf_lo(ga.x); sa[1] = bf_hi(ga.x); sa[2] = bf_lo(ga.y); sa[3] = bf_hi(ga.y); sa[4] = bf_lo(ga.z); sa[5] = bf_hi(ga.z); sa[6] = bf_lo(ga.w); sa[7] = bf_hi(ga.w);
#pragma unroll
                        for (int j = 0; j < 4; ++j) { acc[ai][bj][m][0][j] *= sa[j] * __builtin_amdgcn_rcpf(sb[j]); acc[ai][bj][m][1][j] *= sa[4 + j] * __builtin_amdgcn_rcpf(sb[4 + j]); }
                    } else {
                        float y[8];
#pragma unroll
                        for (int j = 0; j < 4; ++j) { y[j] = acc[ai][bj][m][0][j] * sb[j]; y[4 + j] = acc[ai][bj][m][1][j] * sb[4 + j]; }
                        u32x4 w; w.x = cvt_pk_bf16(y[0], y[1]); w.y = cvt_pk_bf16(y[2], y[3]); w.z = cvt_pk_bf16(y[4], y[5]); w.w = cvt_pk_bf16(y[6], y[7]);
                        *(u32x4*)(Y + r * DM + c) = w;
                    } } }
        return u.half == 0;
    }
};
struct EpiResid {
    static constexpr bool PERM = false;
    const float* X; float* O;
    __device__ __forceinline__ bool operator()(f32x4 (&acc)[2][2][4][2], const Unit& u, int wr, int wc, int fr, int fq) const {
        const int row0 = u.pm * BM + wr * 64 + fr, col0 = u.pn * BM + wc * 32 + 4 * fq;
#pragma unroll
        for (int ai = 0; ai < 2; ++ai)
#pragma unroll
            for (int m = 0; m < 4; ++m) { const size_t off = (size_t)(row0 + ai * HALF + m * 16) * DM + col0;
#pragma unroll
                for (int bj = 0; bj < 2; ++bj)
#pragma unroll
                    for (int n = 0; n < 2; ++n) { const f32x4 xv = *(const f32x4*)(X + off + bj * HALF + n * 16); *(f32x4*)(O + off + bj * HALF + n * 16) = xv + acc[ai][bj][m][n]; } }
        return false;
    }
};

typedef int i32x4v __attribute__((ext_vector_type(4)));
typedef int i32x8v __attribute__((ext_vector_type(8)));
template <class Epi, class Sched, bool ALIGN_EPI = false, bool SP2 = false, bool FP8 = false>
__device__ __forceinline__ void gemm_phase(PG8_LAS unsigned char* lds, const Gemm g, const Sched& S, const Epi& E) {
    const int tid = threadIdx.x, wid = __builtin_amdgcn_readfirstlane(tid >> 6), lane = tid & 63, wr = wid >> 2, wc = wid & 3, fr = lane & 15, fq = lane >> 4;
    const int K = g.K, nt = K / BK;
    unsigned voffA[2], voffB[2];
#pragma unroll
    for (int i = 0; i < 2; ++i) { int R, C; stage_rc(tid * 16 + i * 8192, R, C); const int Rb = Epi::PERM ? ((R & ~31) + perm32(R & 31)) : R;
        voffA[i] = (unsigned)(R * K + C) * 2u; voffB[i] = (unsigned)(Rb * K + C) * 2u; }
    const size_t kstep = (size_t)(BK * 2);
    const size_t hstep = (size_t)HALF * K * 2;
    const size_t tstep = 2 * hstep;
    const unsigned ldsw = (unsigned)wid * 1024u;
    const int aoff = lds_byte(wr * 64 + fr, fq * 8), boff = lds_byte(wc * 32 + fr, fq * 8);
#define PG8_SA(b, h) (((b) * 2 + (h)) * HTB)
#define PG8_SB(b, h) ((4 + (b) * 2 + (h)) * HTB)
#define PG8_STAGE(bufoff, gbase, voff) do { _Pragma("unroll") for (int _i = 0; _i < 2; ++_i) \
        __builtin_amdgcn_global_load_lds((const unsigned*)((const char*)(gbase) + (voff)[_i]), (PG8_LAS unsigned*)(lds + (bufoff) + ldsw + _i * 8192), 16, 0, 0); } while (0)
#define PG8_CAT8(lo_, hi_) __builtin_shufflevector(__builtin_bit_cast(i32x4v, lo_), __builtin_bit_cast(i32x4v, hi_), 0, 1, 2, 3, 4, 5, 6, 7)
#define PG8_LDA(dst, b, h) do { _Pragma("unroll") for (int m = 0; m < 4; ++m) { const bf16x8 lo_ = *(const PG8_LAS bf16x8*)(lds + PG8_SA(b, h) + aoff + m * 2048), hi_ = *(const PG8_LAS bf16x8*)(lds + PG8_SA(b, h) + aoff + m * 2048 + 1024); \
        if constexpr (FP8) dst##8[m] = PG8_CAT8(lo_, hi_); else { dst[m][0] = lo_; dst[m][1] = hi_; } } } while (0)
#define PG8_LDB(dst, b, h) do { _Pragma("unroll") for (int n = 0; n < 2; ++n) { const bf16x8 lo_ = *(const PG8_LAS bf16x8*)(lds + PG8_SB(b, h) + boff + n * 2048), hi_ = *(const PG8_LAS bf16x8*)(lds + PG8_SB(b, h) + boff + n * 2048 + 1024); \
        if constexpr (FP8) dst##8[n] = PG8_CAT8(lo_, hi_); else { dst[n][0] = lo_; dst[n][1] = hi_; } } } while (0)
#define PG8_MMA(ai, bj, At, Bt) do { __builtin_amdgcn_s_setprio(1); \
        if constexpr (FP8) { _Pragma("unroll") for (int m = 0; m < 4; ++m) _Pragma("unroll") for (int n = 0; n < 2; ++n) \
            asm volatile("v_mfma_scale_f32_16x16x128_f8f6f4 %0, %1, %2, %0, %3, %3 op_sel_hi:[0,0,0]" : "+v"(acc[ai][bj][m][n]) : "v"(Bt##8[n]), "v"(At##8[m]), "v"(mxone)); \
        } else { _Pragma("unroll") for (int m = 0; m < 4; ++m) _Pragma("unroll") for (int n = 0; n < 2; ++n) _Pragma("unroll") for (int k = 0; k < 2; ++k) \
            acc[ai][bj][m][n] = __builtin_amdgcn_mfma_f32_16x16x32_bf16(Bt[n][k], At[m][k], acc[ai][bj][m][n], 0, 0, 0); } \
        __builtin_amdgcn_s_setprio(0); } while (0)
#define PG8_WAIT_V(n) asm volatile("s_waitcnt vmcnt(" #n ")" ::: "memory")
#define PG8_WAIT_L(n) asm volatile("s_waitcnt lgkmcnt(" #n ")" ::: "memory")
#define PG8_BAR __builtin_amdgcn_s_barrier()
#define PG8_SCHED __builtin_amdgcn_sched_barrier(0)
    Unit cur, nxt; int ui = 0;
    if (!S.next(0, cur)) return;
    f32x4 acc[2][2][4][2];
#pragma unroll
    for (int a = 0; a < 2; ++a)
#pragma unroll
        for (int b = 0; b < 2; ++b)
#pragma unroll
            for (int m = 0; m < 4; ++m)
#pragma unroll
                for (int n = 0; n < 2; ++n) acc[a][b][m][n] = (f32x4){0.f, 0.f, 0.f, 0.f};
    bf16x8 At[4][2], B0[2][2], B1[2][2];
    const int mxone = 0x7f7f7f7f;
    i32x8v At8[4], B08[2], B18[2];
    const char* cA = (const char*)(cur.half ? g.A2 : g.A) + (size_t)cur.pm * tstep; const char* cB = (const char*)(cur.half ? g.Bt2 : g.Bt) + (size_t)cur.pn * tstep;
    if constexpr (SP2) {
        PG8_STAGE(PG8_SB(0, 0), cB, voffB); PG8_STAGE(PG8_SB(0, 1), cB + hstep, voffB); PG8_STAGE(PG8_SA(0, 0), cA, voffA); PG8_STAGE(PG8_SA(0, 1), cA + hstep, voffA);
        if (wr == 1) PG8_BAR;
        PG8_WAIT_V(2); PG8_BAR;
        PG8_STAGE(PG8_SB(1, 0), cB + kstep, voffB); PG8_STAGE(PG8_SA(1, 0), cA + kstep, voffA); PG8_STAGE(PG8_SB(1, 1), cB + hstep + kstep, voffB);
        PG8_WAIT_V(6); PG8_BAR;
    } else {
        PG8_STAGE(PG8_SB(0, 0), cB, voffB); PG8_STAGE(PG8_SA(0, 0), cA, voffA); PG8_STAGE(PG8_SB(0, 1), cB + hstep, voffB); PG8_STAGE(PG8_SA(0, 1), cA + hstep, voffA);
        if (wr == 1) PG8_BAR;
        PG8_WAIT_V(4); PG8_BAR;
        PG8_STAGE(PG8_SB(1, 0), cB + kstep, voffB); PG8_STAGE(PG8_SA(1, 0), cA + kstep, voffA); PG8_STAGE(PG8_SB(1, 1), cB + hstep + kstep, voffB);
        PG8_WAIT_V(6); PG8_BAR;
    }
    for (;;) {
        const bool has_next = S.next(ui + 1, nxt);
        const char* nA = has_next ? (const char*)(nxt.half ? g.A2 : g.A) + (size_t)nxt.pm * tstep : cA; const char* nB = has_next ? (const char*)(nxt.half ? g.Bt2 : g.Bt) + (size_t)nxt.pn * tstep : cB;
        for (int t = 0; t < nt; t += 2) {
            const bool last = (t == nt - 2);
            const char* a1 = cA + (size_t)(t + 1) * kstep;
            const char* a2 = last ? nA : cA + (size_t)(t + 2) * kstep; const char* b2 = last ? nB : cB + (size_t)(t + 2) * kstep;
            const char* a3 = a2 + kstep; const char* b3 = b2 + kstep;
            if constexpr (SP2) {
            PG8_LDB(B0, 0, 0); PG8_LDB(B1, 0, 1); PG8_SCHED; PG8_LDA(At, 0, 0); PG8_STAGE(PG8_SA(1, 1), a1 + hstep, voffA);
            PG8_WAIT_V(8); PG8_WAIT_L(0); PG8_BAR; PG8_MMA(0, 0, At, B0); PG8_MMA(0, 1, At, B1); PG8_BAR; PG8_SCHED;
            PG8_LDA(At, 0, 1); PG8_STAGE(PG8_SB(0, 0), b2, voffB); PG8_STAGE(PG8_SB(0, 1), b2 + hstep, voffB); PG8_STAGE(PG8_SA(0, 0), a2, voffA);
            PG8_WAIT_V(8); PG8_WAIT_L(0); PG8_BAR; PG8_MMA(1, 0, At, B0); PG8_MMA(1, 1, At, B1); PG8_BAR; PG8_SCHED;
            PG8_LDB(B0, 1, 0); PG8_LDB(B1, 1, 1); PG8_SCHED; PG8_LDA(At, 1, 0); PG8_STAGE(PG8_SA(0, 1), a2 + hstep, voffA);
            PG8_WAIT_V(8); PG8_WAIT_L(0); PG8_BAR; PG8_MMA(0, 0, At, B0); PG8_MMA(0, 1, At, B1); PG8_BAR; PG8_SCHED;
            PG8_LDA(At, 1, 1); PG8_STAGE(PG8_SB(1, 0), b3, voffB); PG8_STAGE(PG8_SB(1, 1), b3 + hstep, voffB); PG8_STAGE(PG8_SA(1, 0), a3, voffA);
            PG8_WAIT_V(8); PG8_WAIT_L(0); PG8_BAR; PG8_MMA(1, 0, At, B0); PG8_MMA(1, 1, At, B1); PG8_BAR; PG8_SCHED;
            } else {
            PG8_LDB(B0, 0, 0); PG8_SCHED; PG8_LDA(At, 0, 0); PG8_STAGE(PG8_SA(1, 1), a1 + hstep, voffA);
            PG8_WAIT_L(8); PG8_BAR; PG8_WAIT_L(0); PG8_MMA(0, 0, At, B0); PG8_BAR; PG8_SCHED;
            PG8_LDB(B1, 0, 1); PG8_STAGE(PG8_SB(0, 0), b2, voffB);
            PG8_BAR; PG8_WAIT_L(0); PG8_MMA(0, 1, At, B1); PG8_BAR;
            PG8_LDA(At, 0, 1); PG8_STAGE(PG8_SA(0, 0), a2, voffA);
            PG8_BAR; PG8_WAIT_L(0); PG8_MMA(1, 0, At, B0); PG8_BAR; PG8_SCHED;
            PG8_STAGE(PG8_SB(0, 1), b2 + hstep, voffB);
            PG8_WAIT_V(6); PG8_BAR; PG8_MMA(1, 1, At, B1); PG8_BAR;
            PG8_LDB(B0, 1, 0); PG8_SCHED; PG8_LDA(At, 1, 0); PG8_STAGE(PG8_SA(0, 1), a2 + hstep, voffA);
            PG8_WAIT_L(8); PG8_BAR; PG8_WAIT_L(0); PG8_MMA(0, 0, At, B0); PG8_BAR; PG8_SCHED;
            PG8_LDB(B1, 1, 1); PG8_STAGE(PG8_SB(1, 0), b3, voffB);
            PG8_BAR; PG8_WAIT_L(0); PG8_MMA(0, 1, At, B1); PG8_BAR;
            PG8_LDA(At, 1, 1); PG8_STAGE(PG8_SA(1, 0), a3, voffA);
            PG8_BAR; PG8_WAIT_L(0); PG8_MMA(1, 0, At, B0); PG8_BAR; PG8_SCHED;
            PG8_STAGE(PG8_SB(1, 1), b3 + hstep, voffB);
            PG8_WAIT_V(6); PG8_BAR; PG8_MMA(1, 1, At, B1); PG8_BAR;
            }
        }
        if constexpr (ALIGN_EPI) { if (wr == 0) PG8_BAR; }
        if constexpr (FP8) {
            asm volatile("s_nop 15\n\ts_nop 15" ::: "memory");
#pragma unroll
            for (int a = 0; a < 2; ++a)
#pragma unroll
                for (int b = 0; b < 2; ++b)
#pragma unroll
                    for (int m = 0; m < 4; ++m)
#pragma unroll
                        for (int n = 0; n < 2; ++n) asm volatile("" : "+v"(acc[a][b][m][n]));
        }
        const bool keep = E(acc, cur, wr, wc, fr, fq);
        if (!has_next) break;
        if (!keep)
#pragma unroll
        for (int a = 0; a < 2; ++a)
#pragma unroll
            for (int b = 0; b < 2; ++b)
#pragma unroll
                for (int m = 0; m < 4; ++m)
#pragma unroll
                    for (int n = 0; n < 2; ++n) acc[a][b][m][n] = (f32x4){0.f, 0.f, 0.f, 0.f};
        cur = nxt; cA = nA; cB = nB; ++ui;
        if constexpr (ALIGN_EPI) { if (wr == 1) PG8_BAR; }
    }
    PG8_WAIT_V(0);
    if constexpr (!ALIGN_EPI) { if (wr == 0) PG8_BAR; }
    PG8_BAR;
#undef PG8_SA
#undef PG8_SB
#undef PG8_STAGE
#undef PG8_LDA
#undef PG8_CAT8
#undef PG8_LDB
#undef PG8_MMA
#undef PG8_WAIT_V
#undef PG8_WAIT_L
#undef PG8_BAR
#undef PG8_SCHED
}}

#define LAS __attribute__((address_space(3)))
typedef unsigned short bf16_t;
typedef short bf16x8 __attribute__((ext_vector_type(8)));
typedef short s16x4 __attribute__((ext_vector_type(4)));
typedef float f32x4 __attribute__((ext_vector_type(4)));
typedef unsigned u32x4 __attribute__((ext_vector_type(4)));
typedef unsigned u32x2 __attribute__((ext_vector_type(2)));
typedef float f32x2 __attribute__((ext_vector_type(2)));
#define LDS_WAIT() asm volatile("s_waitcnt lgkmcnt(0)" ::: "memory")
#define LBAR() do { asm volatile("s_waitcnt lgkmcnt(0)" ::: "memory"); __builtin_amdgcn_s_barrier(); asm volatile("" ::: "memory"); } while (0)
__device__ __forceinline__ float bf2f(bf16_t b) { return __uint_as_float(((unsigned)b) << 16); }
typedef __bf16 bf16x2n __attribute__((ext_vector_type(2)));
typedef float f32x2c __attribute__((ext_vector_type(2)));
__device__ __forceinline__ unsigned pk2(float lo, float hi) { const bf16x2n v = __builtin_convertvector((f32x2c){lo, hi}, bf16x2n); return __builtin_bit_cast(unsigned, v); }
__device__ __forceinline__ unsigned f2bf(float f) { return pk2(f, 0.f) & 0xffffu; }
__device__ __forceinline__ float wave_sum(float v) {
#pragma unroll
    for (int o = 1; o < 64; o <<= 1) v += __shfl_xor(v, o);
    return v;
}
__device__ __forceinline__ bf16x8 rd128(LAS unsigned char* p) { return *(const LAS bf16x8*)p; }
__device__ __forceinline__ bf16x8 trpair(LAS unsigned char* base, int stride, int r0, int r1, int c0, int li) {
    const int q = li >> 2, p = li & 3;
    const s16x4 a = __builtin_amdgcn_ds_read_tr16_b64_v4i16((LAS s16x4*)(base + (r0 + q) * stride + (c0 + 4 * p) * 2));
    const s16x4 b = __builtin_amdgcn_ds_read_tr16_b64_v4i16((LAS s16x4*)(base + (r1 + q) * stride + (c0 + 4 * p) * 2));
    return __builtin_shufflevector(a, b, 0, 1, 2, 3, 4, 5, 6, 7);
}
typedef unsigned u32x2s __attribute__((ext_vector_type(2)));
__device__ __forceinline__ float xg_max(float x) {
    const u32x2s a = __builtin_amdgcn_permlane16_swap(__float_as_uint(x), __float_as_uint(x), false, false);
    const float m = fmaxf(__uint_as_float(a.x), __uint_as_float(a.y));
    const u32x2s b = __builtin_amdgcn_permlane32_swap(__float_as_uint(m), __float_as_uint(m), false, false);
    return fmaxf(__uint_as_float(b.x), __uint_as_float(b.y));
}
__device__ __forceinline__ float xg_sum(float x) {
    const u32x2s a = __builtin_amdgcn_permlane16_swap(__float_as_uint(x), __float_as_uint(x), false, false);
    const float m = __uint_as_float(a.x) + __uint_as_float(a.y);
    const u32x2s b = __builtin_amdgcn_permlane32_swap(__float_as_uint(m), __float_as_uint(m), false, false);
    return __uint_as_float(b.x) + __uint_as_float(b.y);
}
#define MFMA16(A, B, C) __builtin_amdgcn_mfma_f32_16x16x32_bf16((A), (B), (C), 0, 0, 0)

#define XB_TMO      128
#define XB_XCNT(j)  (256  + 64 * (j))
#define XB_XSUB(j)  (1280 + 64 * (j))
#define XB_XGEN(j)  (2304 + 64 * (j))
#define XB_TOP      3328
#define XB_TOPGEN   3392
#define XCD_BAR_WORDS 3456
#define XB_SPIN_CAP (1u << 18)

__device__ __forceinline__ unsigned xb_ld(unsigned* p)              { return __hip_atomic_load(p, __ATOMIC_RELAXED, __HIP_MEMORY_SCOPE_AGENT); }
__device__ __forceinline__ unsigned xb_add(unsigned* p, unsigned v) { return __hip_atomic_fetch_add(p, v, __ATOMIC_RELAXED, __HIP_MEMORY_SCOPE_AGENT); }
__device__ __forceinline__ unsigned xb_xcc_id() { return (unsigned)__builtin_amdgcn_s_getreg((3 << 11) | 20) & 0xFu; }
#define XB_SPIN(cond, bar) do { unsigned _sp = 0; while (cond) { __builtin_amdgcn_s_sleep(1); \
    if ((++_sp & 255u) == 0u) { if (xb_ld(&(bar)[XB_TMO])) break; if (_sp > XB_SPIN_CAP) { atomicAdd(&(bar)[XB_TMO], 1u); break; } } } } while (0)

struct XcdBarrier {
    unsigned* bar; unsigned x;
    volatile LAS unsigned* st;
};

__device__ __forceinline__ XcdBarrier xcd_barrier_post(unsigned* bar, volatile LAS unsigned* st) {
    XcdBarrier b; b.bar = bar; b.x = xb_xcc_id(); b.st = st;
    if (threadIdx.x == 0) (void)xb_add(&bar[XB_XCNT(b.x)], 1u);
    return b;
}
__device__ __forceinline__ void xcd_barrier_complete(unsigned* bar, unsigned x, unsigned& nloc, unsigned& nx) {
    const unsigned G = gridDim.x * gridDim.y * gridDim.z;
    unsigned sum, cnt, mine, sp = 0u;
    for (;;) {
        sum = 0u; cnt = 0u; mine = 0u;
#pragma unroll
        for (unsigned j = 0; j < 16; ++j) { const unsigned c = xb_ld(&bar[XB_XCNT(j)]); sum += c; cnt += (c > 0u) ? 1u : 0u; mine = (j == x) ? c : mine; }
        if (sum == G) break;
        __builtin_amdgcn_s_sleep(1);
        if ((++sp & 255u) == 0u) { if (xb_ld(&bar[XB_TMO])) break; if (sp > XB_SPIN_CAP) { atomicAdd(&bar[XB_TMO], 1u); break; } }
    }
    nloc = mine > 0u ? mine : 1u; nx = cnt > 0u ? cnt : 1u;
}

__device__ __forceinline__ void xcd_barrier(const XcdBarrier& b) {
    asm volatile("s_waitcnt vmcnt(0)" ::: "memory");
    __syncthreads();
    if (threadIdx.x == 0) {
        unsigned* bar = b.bar;
        __builtin_amdgcn_s_waitcnt(0);
        unsigned nloc = b.st[0], nx = b.st[1];
        if (nloc == 0u) { xcd_barrier_complete(bar, b.x, nloc, nx); b.st[0] = nloc; b.st[1] = nx; }
        const unsigned old = xb_add(&bar[XB_XSUB(b.x)], 1u);
        const unsigned gen = old / nloc;
        if (old + 1u == (gen + 1u) * nloc) {
            __builtin_amdgcn_fence(__ATOMIC_RELEASE, "agent");
            asm volatile("s_waitcnt vmcnt(0)" ::: "memory");
            const unsigned og = xb_add(&bar[XB_TOP], 1u);
            const unsigned tg = og / nx;
            if (og + 1u == (tg + 1u) * nx) xb_add(&bar[XB_TOPGEN], 1u);
            else XB_SPIN(xb_ld(&bar[XB_TOPGEN]) == tg, bar);
            __builtin_amdgcn_fence(__ATOMIC_ACQUIRE, "agent");
            xb_add(&bar[XB_XGEN(b.x)], 1u);
            asm volatile("s_waitcnt vmcnt(0)" ::: "memory");
        } else {
            XB_SPIN(xb_ld(&bar[XB_XGEN(b.x)]) == gen, bar);
            __builtin_amdgcn_fence(__ATOMIC_ACQUIRE, "agent");
            asm volatile("s_waitcnt vmcnt(0)" ::: "memory");
        }
    }
    __syncthreads();
}


constexpr size_t MiB = 1u << 20;
constexpr size_t WS_CTL = 0;
constexpr size_t WS_WIN = 1 * MiB;
constexpr size_t WS_WA  = WS_WIN + 192 * MiB;
constexpr size_t WS_WB  = WS_WA + 16 * MiB;
constexpr size_t WS_WO  = WS_WB + 16 * MiB;
constexpr size_t WS_U   = WS_WO + 32 * MiB;
constexpr size_t WS_PROJ = WS_U + 64 * MiB;
constexpr size_t WS_OA  = WS_PROJ + 384 * MiB;
constexpr size_t WS_OB  = WS_OA + 32 * MiB;
constexpr size_t WS_Y   = WS_OB + 32 * MiB;
constexpr size_t WS_W8  = WS_WIN + 128 * MiB;
constexpr size_t WS_U8  = WS_Y + 64 * MiB;
constexpr size_t WS_END = WS_U8 + 32 * MiB;

constexpr int LDS_MISC = 139264;
constexpr int LDS_BYTES = LDS_MISC + 256;
constexpr int NWAVES = 8, NTHR = 512;

struct Args { const float* in[14]; float* out; unsigned char* ws; int ph_lo, ph_hi; };

__device__ __forceinline__ void p0_transpose_item(const float* W, int K, int N, bf16_t* WT, LAS float* scr, int item, int lane) {
    const int nblk = N / 32, kb = item / nblk, nb = item % nblk, k0 = 64 * kb, n0 = 32 * nb;
#pragma unroll 8
    for (int i = 0; i < 32; ++i) { const int kk = 2 * i + (lane >> 5); scr[kk * 33 + (lane & 31)] = __builtin_nontemporal_load(W + (size_t)(k0 + kk) * N + n0 + (lane & 31)); }
    LDS_WAIT();
    const int c = lane & 7;
#pragma unroll
    for (int j = 0; j < 4; ++j) { const int n = (lane >> 3) + 8 * j; const LAS float* s = scr + (8 * c) * 33 + n;
        u32x4 o; o.x = pk2(s[0 * 33], s[1 * 33]); o.y = pk2(s[2 * 33], s[3 * 33]); o.z = pk2(s[4 * 33], s[5 * 33]); o.w = pk2(s[6 * 33], s[7 * 33]);
        *(u32x4*)(WT + (size_t)(n0 + n) * K + k0 + 8 * c) = o; }
    LDS_WAIT();
}
__device__ __forceinline__ unsigned pk4_fp8(float a, float b, float c, float d) { int w = 0; w = __builtin_amdgcn_cvt_pk_fp8_f32(a, b, w, false); w = __builtin_amdgcn_cvt_pk_fp8_f32(c, d, w, true); return (unsigned)w; }
__device__ __forceinline__ void p0_transpose_item_f8(const float* W, unsigned char* WT8, LAS float* scr, int item, int lane) {
    constexpr int K = DM, N = NIN, nblk = 8192 / 32;
    const int kb = item / nblk, nb = item % nblk, k0 = 64 * kb, n0 = 32 * nb;
#pragma unroll 8
    for (int i = 0; i < 32; ++i) { const int kk = 2 * i + (lane >> 5); scr[kk * 33 + (lane & 31)] = __builtin_nontemporal_load(W + (size_t)(k0 + kk) * N + C_GA + n0 + (lane & 31)); }
    LDS_WAIT();
    const int c = lane & 7;
#pragma unroll
    for (int j = 0; j < 4; ++j) { const int n = (lane >> 3) + 8 * j; const LAS float* sp = scr + (8 * c) * 33 + n;
        u32x2 o; o.x = pk4_fp8(sp[0 * 33] * 64.f, sp[1 * 33] * 64.f, sp[2 * 33] * 64.f, sp[3 * 33] * 64.f); o.y = pk4_fp8(sp[4 * 33] * 64.f, sp[5 * 33] * 64.f, sp[6 * 33] * 64.f, sp[7 * 33] * 64.f);
        __builtin_nontemporal_store(o, (u32x2*)(WT8 + (size_t)(n0 + n) * K + k0 + 8 * c)); }
    LDS_WAIT();
}
__device__ __forceinline__ void rms_row(const float* xrow, const float* wv, bf16_t* obf, float* of32, float eps, int lane, unsigned* o8f = nullptr) {
    const f32x4* xr = (const f32x4*)xrow + lane;
    f32x4 v[16]; float s = 0.f;
#pragma unroll
    for (int j = 0; j < 16; ++j) { v[j] = __builtin_nontemporal_load(xr + 64 * j); s += (v[j].x * v[j].x + v[j].y * v[j].y) + (v[j].z * v[j].z + v[j].w * v[j].w); }
    const float rstd = rsqrtf(wave_sum(s) * (1.f / DM) + eps);
    const f32x4* wr = (const f32x4*)wv + lane;
    if (obf) { unsigned long long* o8 = (unsigned long long*)obf + lane;
#pragma unroll
        for (int j = 0; j < 16; ++j) { const f32x4 w4 = wr[64 * j]; const f32x4 y = v[j] * rstd * w4; o8[64 * j] = (unsigned long long)pk2(y.x, y.y) | ((unsigned long long)pk2(y.z, y.w) << 32);
            if (o8f) __builtin_nontemporal_store(pk4_fp8(y.x, y.y, y.z, y.w), o8f + lane + 64 * j); }
    } else { f32x4* o = (f32x4*)of32 + lane;
#pragma unroll
        for (int j = 0; j < 16; ++j) { const f32x4 w4 = wr[64 * j]; o[64 * j] = v[j] * rstd * w4; }
    }
}

__device__ __forceinline__ void rms_row_resid(const float* xrow, const bf16_t* drow, const float* wv, float* orow, float eps, int lane) {
    const f32x4* xr = (const f32x4*)xrow + lane; const u32x2* dr = (const u32x2*)drow + lane;
    f32x4 v[16]; float s = 0.f;
#pragma unroll
    for (int j = 0; j < 16; ++j) { const u32x2 d = dr[64 * j]; v[j] = xr[64 * j] + (f32x4){pg8::bf_lo(d.x), pg8::bf_hi(d.x), pg8::bf_lo(d.y), pg8::bf_hi(d.y)};
        s += (v[j].x * v[j].x + v[j].y * v[j].y) + (v[j].z * v[j].z + v[j].w * v[j].w); }
    const float rstd = rsqrtf(wave_sum(s) * (1.f / DM) + eps);
    const f32x4* wr = (const f32x4*)wv + lane; f32x4* o = (f32x4*)orow + lane;
#pragma unroll
    for (int j = 0; j < 16; ++j) { const f32x4 w4 = wr[64 * j]; o[64 * j] = v[j] * rstd * w4; }
}

constexpr int HS = 272, SCS = 144;
constexpr int H_QD = 0, H_KI = 17408, H_KE = 34816, H_VV = 52224, H_ST = 69632, H_SC = 104448, H_DEC = 113664, H_PS = 114176, H_RS = 118272;
__device__ __forceinline__ void hgrn_item(LAS unsigned char* lds, const bf16_t* PROJ, bf16_t* OA, const float* lbt, const float* hnw, int item) {
    const int tid = threadIdx.x, lane = tid & 63, w = __builtin_amdgcn_readfirstlane(tid >> 6), g = lane >> 4, li = lane & 15;
    const int b = item >> 4, h = item & 15;
    const bf16_t* P = PROJ + (size_t)(b * SEQ) * NIN;
    const int kp = tid & 63, part = w;
    float lb[2], oml[2];
#pragma unroll
    for (int e = 0; e < 2; ++e) { const float t0 = lbt[h * 128 + 2 * kp + e], t1 = lbt[2048 + h * 128 + 2 * kp + e]; lb[e] = 1.f / (1.f + __expf(t1 - t0)); oml[e] = 1.f - lb[e]; }
    LAS float* DEC = (LAS float*)(lds + H_DEC); LAS float* PS = (LAS float*)(lds + H_PS); LAS float* RS = (LAS float*)(lds + H_RS);
    for (int i = tid; i < 34816 / 16; i += NTHR) *(LAS u32x4*)(lds + H_ST + i * 16) = (u32x4){0u, 0u, 0u, 0u};
    f32x4 st[8];
#pragma unroll
    for (int i = 0; i < 8; ++i) st[i] = (f32x4){0.f, 0.f, 0.f, 0.f};
    unsigned zr[8], qr[8], vr[8];
    { const bf16_t* p0 = P + (size_t)(part * 8) * NIN + h * 128 + 2 * kp;
#pragma unroll
      for (int i = 0; i < 8; ++i) { zr[i] = *(const unsigned*)(p0 + (size_t)i * NIN + C_AF); qr[i] = *(const unsigned*)(p0 + (size_t)i * NIN + C_AQ); vr[i] = *(const unsigned*)(p0 + (size_t)i * NIN + C_AI); } }
    const int ct = w & 3, vb = 4 * (w >> 2);
    for (int n = 0; n < SEQ / 64; ++n) {
        float lf[8][2], kg[8][2];
        float run[2] = {1.f, 1.f};
#pragma unroll
        for (int i = 0; i < 8; ++i)
#pragma unroll
            for (int e = 0; e < 2; ++e) {
                const float z = e ? pg8::bf_hi(zr[i]) : pg8::bf_lo(zr[i]); const float ex = __expf(-fabsf(z)), r = __builtin_amdgcn_rcpf(1.f + ex), sp = r, sn = ex * r;
                const float sg = z >= 0.f ? sp : sn, sgm = z >= 0.f ? sn : sp;
                run[e] *= (lb[e] + oml[e] * sg); lf[i][e] = run[e]; kg[i][e] = oml[e] * sgm;
            }
        *(LAS f32x2*)(PS + part * 128 + 2 * kp) = (f32x2){run[0], run[1]};
        LBAR();
        float off[2] = {1.f, 1.f}, bl[2] = {1.f, 1.f};
#pragma unroll
        for (int p = 0; p < 8; ++p) { const f32x2 t = *(const LAS f32x2*)(PS + p * 128 + 2 * kp); bl[0] *= t.x; bl[1] *= t.y; off[0] *= (p < part) ? t.x : 1.f; off[1] *= (p < part) ? t.y : 1.f; }
#pragma unroll
        for (int i = 0; i < 8; ++i) { const int r = part * 8 + i;
            const float eb0 = off[0] * lf[i][0], eb1 = off[1] * lf[i][1], ki0 = kg[i][0] * __builtin_amdgcn_rcpf(eb0), ki1 = kg[i][1] * __builtin_amdgcn_rcpf(eb1);
            *(LAS unsigned*)(lds + H_QD + r * HS + kp * 4) = pk2(pg8::bf_lo(qr[i]) * eb0, pg8::bf_hi(qr[i]) * eb1);
            *(LAS unsigned*)(lds + H_KI + r * HS + kp * 4) = pk2(ki0, ki1);
            *(LAS unsigned*)(lds + H_VV + r * HS + kp * 4) = vr[i]; }
        if (part == 0) *(LAS f32x2*)(DEC + 2 * kp) = (f32x2){bl[0], bl[1]};
        if (n + 1 < SEQ / 64) { const bf16_t* p0 = P + (size_t)((n + 1) * 64 + part * 8) * NIN + h * 128 + 2 * kp;
#pragma unroll
            for (int i = 0; i < 8; ++i) { zr[i] = *(const unsigned*)(p0 + (size_t)i * NIN + C_AF); qr[i] = *(const unsigned*)(p0 + (size_t)i * NIN + C_AQ); vr[i] = *(const unsigned*)(p0 + (size_t)i * NIN + C_AI); } }
        u32x2 gr[4];
#pragma unroll
        for (int u = 0; u < 4; ++u) gr[u] = *(const u32x2*)(P + (size_t)(n * 64 + 16 * ct + li) * NIN + C_AG + h * 128 + 16 * (vb + u) + 4 * g);
        LBAR();
        bf16x8 QDf[4];
#pragma unroll
        for (int ks = 0; ks < 4; ++ks) QDf[ks] = rd128(lds + H_QD + (16 * ct + li) * HS + (32 * ks + 8 * g) * 2);
        bf16x8 Pf[2];
#pragma unroll
        for (int a2 = 0; a2 < 2; ++a2) { f32x4 sa[2];
#pragma unroll
            for (int t = 0; t < 2; ++t) { const int stl = 2 * a2 + t; sa[t] = (f32x4){0.f, 0.f, 0.f, 0.f};
                if (stl <= ct) {
#pragma unroll
                    for (int ks = 0; ks < 4; ++ks) sa[t] = MFMA16(rd128(lds + H_KI + (16 * stl + li) * HS + (32 * ks + 8 * g) * 2), QDf[ks], sa[t]);
                    if (stl == ct) {
#pragma unroll
                        for (int j = 0; j < 4; ++j) sa[t][j] = (4 * g + j <= li) ? sa[t][j] : 0.f; } } }
            u32x4 tt; tt.x = pk2(sa[0][0], sa[0][1]); tt.y = pk2(sa[0][2], sa[0][3]); tt.z = pk2(sa[1][0], sa[1][1]); tt.w = pk2(sa[1][2], sa[1][3]);
            Pf[a2] = __builtin_bit_cast(bf16x8, tt); }
        f32x4 oacc[4];
#pragma unroll
        for (int u = 0; u < 4; ++u) oacc[u] = (f32x4){0.f, 0.f, 0.f, 0.f};
#pragma unroll
        for (int a2 = 0; a2 < 2; ++a2)
            if (2 * a2 <= ct) {
#pragma unroll
                for (int u = 0; u < 4; ++u) oacc[u] = MFMA16(trpair(lds + H_VV, HS, 32 * a2 + 4 * g, 32 * a2 + 16 + 4 * g, 16 * (vb + u), li), Pf[a2], oacc[u]); }
#pragma unroll
        for (int ks = 0; ks < 4; ++ks)
#pragma unroll
            for (int u = 0; u < 4; ++u) oacc[u] = MFMA16(rd128(lds + H_ST + (16 * (vb + u) + li) * HS + (32 * ks + 8 * g) * 2), QDf[ks], oacc[u]);
        { float sq = 0.f;
#pragma unroll
          for (int u = 0; u < 4; ++u) sq += (oacc[u][0] * oacc[u][0] + oacc[u][1] * oacc[u][1]) + (oacc[u][2] * oacc[u][2] + oacc[u][3] * oacc[u][3]);
          sq = xg_sum(sq);
          if (g == 0) RS[(w >> 2) * 64 + 16 * ct + li] = sq; }
        { bf16x8 Af[2];
#pragma unroll
          for (int ks2 = 0; ks2 < 2; ++ks2) Af[ks2] = trpair(lds + H_KI, HS, 32 * ks2 + 8 * g, 32 * ks2 + 8 * g + 4, 16 * w, li);
          float dc[4];
#pragma unroll
          for (int j = 0; j < 4; ++j) dc[j] = DEC[16 * w + 4 * g + j];
#pragma unroll
          for (int vt = 0; vt < 8; ++vt) {
#pragma unroll
              for (int ks2 = 0; ks2 < 2; ++ks2) st[vt] = MFMA16(Af[ks2], trpair(lds + H_VV, HS, 32 * ks2 + 8 * g, 32 * ks2 + 8 * g + 4, 16 * vt, li), st[vt]);
#pragma unroll
              for (int j = 0; j < 4; ++j) st[vt][j] *= dc[j]; } }
        LBAR();
#pragma unroll
        for (int vt = 0; vt < 8; ++vt) *(LAS u32x2*)(lds + H_ST + (16 * vt + li) * HS + (16 * w + 4 * g) * 2) = (u32x2){pk2(st[vt][0], st[vt][1]), pk2(st[vt][2], st[vt][3])};
        { const int c = 16 * ct + li; const float tot = RS[c] + RS[64 + c]; const float rstd = rsqrtf(tot * (1.f / 128.f) + 1e-6f);
          bf16_t* orow = OA + ((size_t)(b * SEQ) + (size_t)(n * 64 + c)) * AW + h * 128 + 4 * g;
#pragma unroll
          for (int u = 0; u < 4; ++u) { const f32x4 hw4 = *(const f32x4*)(hnw + 16 * (vb + u) + 4 * g);
              const float g0 = pg8::bf_lo(gr[u].x), g1 = pg8::bf_hi(gr[u].x), g2 = pg8::bf_lo(gr[u].y), g3 = pg8::bf_hi(gr[u].y);
              const float y0 = oacc[u][0] * rstd * hw4.x * g0 * __builtin_amdgcn_rcpf(1.f + __expf(-g0)), y1 = oacc[u][1] * rstd * hw4.y * g1 * __builtin_amdgcn_rcpf(1.f + __expf(-g1));
              const float y2 = oacc[u][2] * rstd * hw4.z * g2 * __builtin_amdgcn_rcpf(1.f + __expf(-g2)), y3 = oacc[u][3] * rstd * hw4.w * g3 * __builtin_amdgcn_rcpf(1.f + __expf(-g3));
              *(u32x2*)(orow + 16 * (vb + u)) = (u32x2){pk2(y0, y1), pk2(y2, y3)}; } }
    }
}

constexpr int KS_ = 272, VS_ = 544;
constexpr int A_K0 = 0, A_K1 = 8704, A_V = 17408, A_BUF = 34816, A_Q0 = 69632, A_Q1 = 104448;
__device__ __forceinline__ void attn_item(LAS unsigned char* lds, const bf16_t* PROJ, bf16_t* OB, const float* subw, float lam, int idx) {
    const int tid = threadIdx.x, lane = tid & 63, w = __builtin_amdgcn_readfirstlane(tid >> 6), g = lane >> 4, li = lane & 15;
    const int qb = 15 - (idx >> 5), bh = idx & 31, b = bh >> 3, h = bh & 7;
    const int q0 = qb * 128 + 16 * w, qpos = q0 + li;
    const bf16_t* P = PROJ + (size_t)(b * SEQ) * NIN;
    const float LOG2E = 1.4426950408889634f;
    const float slope2 = __builtin_amdgcn_exp2f(-(float)(h + 1)) * LOG2E, c1 = 0.08838834764831845f * LOG2E;
    f32x4 o[2][16];
#pragma unroll
    for (int m = 0; m < 2; ++m)
#pragma unroll
        for (int i = 0; i < 16; ++i) o[m][i] = (f32x4){0.f, 0.f, 0.f, 0.f};
    float mrun[2] = {-1e30f, -1e30f}, lrun[2] = {0.f, 0.f};
    u32x4 pf[4];
    const unsigned voK = (unsigned)(((tid >> 4) * NIN + C_BK + h * 256 + (tid & 15) * 8) * 2), voV = (unsigned)(((tid >> 5) * NIN + C_BV + h * 256 + (tid & 31) * 8) * 2);
    const unsigned loK = (unsigned)((tid >> 4) * KS_ + (tid & 15) * 16), loV = (unsigned)((tid >> 5) * VS_ + (tid & 31) * 16);
    const char* Pb = (const char*)P;
#define ATT_PREFETCH(kt) do { const char* pk_ = Pb + (size_t)(kt) * (32 * NIN * 2); \
        pf[0] = *(const u32x4*)(pk_ + voK); pf[1] = *(const u32x4*)(pk_ + 256 + voK); \
        pf[2] = *(const u32x4*)(pk_ + voV); pf[3] = *(const u32x4*)(pk_ + (size_t)(16 * NIN * 2) + voV); } while (0)
#define ATT_WRITE(bo) do { *(LAS u32x4*)(lds + (bo) + A_K0 + loK) = pf[0]; *(LAS u32x4*)(lds + (bo) + A_K1 + loK) = pf[1]; \
        *(LAS u32x4*)(lds + (bo) + A_V + loV) = pf[2]; *(LAS u32x4*)(lds + (bo) + A_V + 16 * VS_ + loV) = pf[3]; } while (0)
    LBAR();
    { const bf16_t* pq = P + (size_t)(qb * 128) * NIN + C_BQ + h * 256;
#pragma unroll
      for (int hh = 0; hh < 2; ++hh) {
#pragma unroll
        for (int i = 0; i < 4; ++i) { const int c = tid + 512 * (4 * hh + i), r = c >> 5, c16 = c & 31; pf[i] = *(const u32x4*)(pq + (size_t)r * NIN + c16 * 8); }
#pragma unroll
        for (int i = 0; i < 4; ++i) { const int c = tid + 512 * (4 * hh + i), r = c >> 5, c16 = c & 31; *(LAS u32x4*)(lds + ((c16 & 16) ? A_Q1 : A_Q0) + r * KS_ + (c16 & 15) * 16) = pf[i]; } } }
    const int nkt = 4 * qb + 4;
    ATT_PREFETCH(0);
    ATT_WRITE(0);
    ATT_PREFETCH(1);
    LBAR();
    LAS unsigned char* Qw = lds + A_Q0 + (16 * w + li) * KS_ + 16 * g;
    for (int kt = 0; kt < nkt; ++kt) {
        const int bo = (kt & 1) * A_BUF;
        if (32 * kt <= q0 + 15) {
            bf16x8 Pf[2]; float alpha[2];
            const int rel = qpos - 32 * kt - 4 * g;
            const float bias0 = -slope2 * (float)rel;
            const bool diag = (32 * kt + 31 > q0);
#pragma unroll
            for (int m = 0; m < 2; ++m) {
                f32x4 s[2];
                s[0] = (f32x4){0.f, 0.f, 0.f, 0.f}; s[1] = (f32x4){0.f, 0.f, 0.f, 0.f};
#pragma unroll
                for (int ks = 0; ks < 4; ++ks) { const bf16x8 qf = rd128(Qw + m * (A_Q1 - A_Q0) + 64 * ks);
#pragma unroll
                    for (int t4 = 0; t4 < 2; ++t4) s[t4] = MFMA16(rd128(lds + bo + (m ? A_K1 : A_K0) + (16 * t4 + li) * KS_ + (32 * ks + 8 * g) * 2), qf, s[t4]); }
                float mx = -1e30f;
#pragma unroll
                for (int t4 = 0; t4 < 2; ++t4)
#pragma unroll
                    for (int j = 0; j < 4; ++j) { float v = fmaf(s[t4][j], c1, bias0) + slope2 * (float)(16 * t4 + j); if (diag) v = ((16 * t4 + j) > rel) ? -1e30f : v; s[t4][j] = v; mx = fmaxf(mx, v); }
                mx = xg_max(mx);
                const float mnew = fmaxf(mrun[m], mx); alpha[m] = __builtin_amdgcn_exp2f(mrun[m] - mnew); mrun[m] = mnew;
                float psum = 0.f;
#pragma unroll
                for (int t4 = 0; t4 < 2; ++t4)
#pragma unroll
                    for (int j = 0; j < 4; ++j) { const float p = __builtin_amdgcn_exp2f(s[t4][j] - mnew); s[t4][j] = p; psum += p; }
                lrun[m] = lrun[m] * alpha[m] + psum;
                u32x4 t; t.x = pk2(s[0][0], s[0][1]); t.y = pk2(s[0][2], s[0][3]); t.z = pk2(s[1][0], s[1][1]); t.w = pk2(s[1][2], s[1][3]);
                Pf[m] = __builtin_bit_cast(bf16x8, t);
            }
            if (__builtin_amdgcn_ballot_w64(alpha[0] != 1.0f || alpha[1] != 1.0f) != 0ull) {
#pragma unroll
                for (int vt = 0; vt < 16; ++vt) { o[0][vt] = o[0][vt] * alpha[0]; o[1][vt] = o[1][vt] * alpha[1]; }
            }
#pragma unroll
            for (int vt = 0; vt < 16; ++vt) { const bf16x8 vf = trpair(lds + bo + A_V, VS_, 4 * g, 16 + 4 * g, 16 * vt, li);
                o[0][vt] = MFMA16(vf, Pf[0], o[0][vt]); o[1][vt] = MFMA16(vf, Pf[1], o[1][vt]); }
        }
        if (kt + 1 < nkt) { ATT_WRITE(A_BUF - bo); if (kt + 2 < nkt) ATT_PREFETCH(kt + 2); }
        LBAR();
    }
#undef ATT_PREFETCH
#undef ATT_WRITE
    float inv[2];
#pragma unroll
    for (int m = 0; m < 2; ++m) inv[m] = 1.f / xg_sum(lrun[m]);
    const float i0 = inv[0], i1 = inv[1] * lam;
    float ss = 0.f;
#pragma unroll
    for (int vt = 0; vt < 16; ++vt) { const f32x4 d = o[0][vt] * i0 - o[1][vt] * i1; o[0][vt] = d; ss += (d.x * d.x + d.y * d.y) + (d.z * d.z + d.w * d.w); }
    ss = xg_sum(ss);
    const float rstd = rsqrtf(ss * (1.f / 256.f) + 1e-5f) * 0.8f;
    const size_t tok = (size_t)(b * SEQ + qpos);
#pragma unroll
    for (int vt = 0; vt < 16; ++vt) { const int v0 = 16 * vt + 4 * g;
        const u32x2 gw = *(const u32x2*)(PROJ + tok * NIN + C_BG + h * 256 + v0); const f32x4 sw = *(const f32x4*)(subw + v0);
        const float g0 = pg8::bf_lo(gw.x), g1 = pg8::bf_hi(gw.x), g2 = pg8::bf_lo(gw.y), g3 = pg8::bf_hi(gw.y);
        const float y0 = o[0][vt].x * rstd * sw.x * g0 * __builtin_amdgcn_rcpf(1.f + __expf(-g0)), y1 = o[0][vt].y * rstd * sw.y * g1 * __builtin_amdgcn_rcpf(1.f + __expf(-g1));
        const float y2 = o[0][vt].z * rstd * sw.z * g2 * __builtin_amdgcn_rcpf(1.f + __expf(-g2)), y3 = o[0][vt].w * rstd * sw.w * g3 * __builtin_amdgcn_rcpf(1.f + __expf(-g3));
        *(u32x2*)(OB + tok * AW + h * 256 + v0) = (u32x2){pk2(y0, y1), pk2(y2, y3)}; }
}

constexpr int N_HGRN = 64, N_ATT = 512, N_ITEMS = N_HGRN + N_ATT;
__global__ void __launch_bounds__(NTHR, 2) mega_fwd(Args a) {
    extern __shared__ __attribute__((aligned(16))) unsigned char lds_raw[];
    LAS unsigned char* lds = (LAS unsigned char*)lds_raw;
    cg::grid_group grid = cg::this_grid();
    const int tid = threadIdx.x, lane = tid & 63, wave = __builtin_amdgcn_readfirstlane(tid >> 6);
    const int G = gridDim.x;
    unsigned char* ws = a.ws;
    unsigned* ctl = (unsigned*)(ws + WS_CTL);
    bf16_t* WIN = (bf16_t*)(ws + WS_WIN); bf16_t* WA = (bf16_t*)(ws + WS_WA); bf16_t* WB = (bf16_t*)(ws + WS_WB); bf16_t* WO = (bf16_t*)(ws + WS_WO);
    bf16_t* U = (bf16_t*)(ws + WS_U); bf16_t* PROJ = (bf16_t*)(ws + WS_PROJ); bf16_t* OA = (bf16_t*)(ws + WS_OA); bf16_t* OB = (bf16_t*)(ws + WS_OB); bf16_t* Y = (bf16_t*)(ws + WS_Y); unsigned char* W8 = ws + WS_W8; unsigned char* U8 = ws + WS_U8;
    const float* x = a.in[0]; const float* norm_w = a.in[1]; const float* w_in = a.in[2]; const float* lbt = a.in[3]; const float* hnw = a.in[4];
    const float* lq1 = a.in[5]; const float* lk1 = a.in[6]; const float* lq2 = a.in[7]; const float* lk2 = a.in[8]; const float* subw = a.in[9];
    const float* w_a = a.in[10]; const float* w_b = a.in[11]; const float* w_o = a.in[12]; const float* final_w = a.in[13];
    const int lo = a.ph_lo, hi = a.ph_hi;
    volatile LAS unsigned* MISCU = (volatile LAS unsigned*)(lds + LDS_MISC);
    if (tid == 0) { MISCU[8] = 0u; MISCU[9] = 0u; }
    __syncthreads();
    XcdBarrier xb = xcd_barrier_post(ctl + 1024, MISCU + 8);
#define IN(k) (lo <= (k) && (k) < hi)
#define SEAM(k) do { if (IN(k) && IN((k) + 1)) xcd_barrier(xb); } while (0)
    if (hi == 777) grid.sync();

    if (IN(0)) {
        if (blockIdx.x == 0 && tid == 0) { __hip_atomic_store(ctl, 0u, __ATOMIC_RELAXED, __HIP_MEMORY_SCOPE_AGENT); __hip_atomic_store(ctl + 64, 0u, __ATOMIC_RELAXED, __HIP_MEMORY_SCOPE_AGENT); __hip_atomic_store(ctl + 128, 0u, __ATOMIC_RELAXED, __HIP_MEMORY_SCOPE_AGENT); }
        LAS float* scr = (LAS float*)(lds + wave * 16384);
        const int gw = blockIdx.x * NWAVES + wave, NGW = G * NWAVES;
        constexpr int I_IN = (DM / 64) * (NIN / 32);
        for (int it = gw; it < 64 * 512; it += NGW) p0_transpose_item(w_in, DM, NIN, WIN, scr, (it >> 9) * (NIN / 32) + (it & 511), lane);
        for (int it = gw; it < 64 * 256; it += NGW) p0_transpose_item_f8(w_in, W8, scr, it, lane);
        for (int mr_ = gw; mr_ < MT * (PROBE_PH == 0 ? 2 : 1); mr_ += NGW) { const int mrow = mr_ % MT; rms_row(x + (size_t)mrow * DM, norm_w, U + (size_t)mrow * DM, nullptr, 1e-6f, lane, (unsigned*)(U8 + (size_t)mrow * DM)); }
    }
    SEAM(0);
    if (IN(1)) {
        { pg8::Gemm g{U, WIN, U, WIN, DM}; pg8::StaticOrder S; S.init(MT, C_GA, G, (int)blockIdx.x);
          pg8::EpiProj E{PROJ, NIN, 0, 1.0f, 0};
          pg8::gemm_phase<pg8::EpiProj, pg8::StaticOrder, true, true, false>(lds, g, S, E); }
        { pg8::Gemm g{(const bf16_t*)U8, (const bf16_t*)W8, (const bf16_t*)U8, (const bf16_t*)W8, DM / 2}; pg8::StaticOrder S; S.init(MT, NIN - C_GA, G, (int)blockIdx.x);
          pg8::EpiProj E{PROJ, NIN, C_GA, 1.0f / 64.0f, 1};
          pg8::gemm_phase<pg8::EpiProj, pg8::StaticOrder, true, true, true>(lds, g, S, E); }
    }
    SEAM(1);
    if (IN(2)) {
        float lam;
        { const float p1 = lq1[lane] * lk1[lane] + lq1[lane + 64] * lk1[lane + 64], p2 = lq2[lane] * lk2[lane] + lq2[lane + 64] * lk2[lane + 64];
          lam = __expf(wave_sum(p1)) - __expf(wave_sum(p2)) + 0.2f; }
        volatile LAS int* MISC = (volatile LAS int*)(lds + LDS_MISC);
        for (;;) {
            LBAR();
            if (tid == 0) MISC[0] = (int)__hip_atomic_fetch_add(ctl, 1u, __ATOMIC_RELAXED, __HIP_MEMORY_SCOPE_AGENT);
            LBAR();
            const int item = MISC[0];
            if (item >= N_HGRN * (PROBE_PH == 2 ? 2 : 1)) break;
            hgrn_item(lds, PROJ, OA, lbt, hnw, item % N_HGRN);
        }
        for (;;) {
            LBAR();
            if (tid == 0) MISC[0] = (int)__hip_atomic_fetch_add(ctl + 64, 1u, __ATOMIC_RELAXED, __HIP_MEMORY_SCOPE_AGENT);
            LBAR();
            const int item = MISC[0];
            if (item >= N_ATT * (PROBE_PH == 2 ? 2 : 1)) break;
            attn_item(lds, PROJ, OB, subw, lam, item % N_ATT);
        }
        { constexpr int I_A = (AW / 64) * (DM / 32), I_O = (DM / 64) * (DM / 32);
          LAS float* scr = (LAS float*)(lds + wave * 16384);
          for (;;) {
            LBAR();
            if (tid == 0) MISC[0] = (int)__hip_atomic_fetch_add(ctl + 128, 1u, __ATOMIC_RELAXED, __HIP_MEMORY_SCOPE_AGENT);
            LBAR();
            const int item = MISC[0];
            if (item >= (2 * I_A + I_O) / NWAVES) break;
            int r = item * NWAVES + wave;
            if (r < I_A) { p0_transpose_item(w_a, AW, DM, WA, scr, r, lane); continue; } r -= I_A;
            if (r < I_A) { p0_transpose_item(w_b, AW, DM, WB, scr, r, lane); continue; } r -= I_A;
            p0_transpose_item(w_o, DM, DM, WO, scr, r, lane);
          } }
    }
    SEAM(2);
    if (IN(3)) {
        pg8::Gemm g{OA, WA, OB, WB, AW}; pg8::ChainOrder S; S.init(MT, DM, G, (int)blockIdx.x, PROBE_PH == 3 ? 2 : 1);
        pg8::EpiMerge E{PROJ, Y};
        pg8::gemm_phase<pg8::EpiMerge, pg8::ChainOrder, true, true>(lds, g, S, E);
    }
    SEAM(3);
    if (IN(4)) {
        pg8::Gemm g{Y, WO, Y, WO, DM}; pg8::StaticOrder S; S.init(MT, DM, G, (int)blockIdx.x, PROBE_PH == 4 ? 2 : 1);
        pg8::EpiProj E{U, DM, 0, 1.0f, 0};
        pg8::gemm_phase<pg8::EpiProj, pg8::StaticOrder, true, true>(lds, g, S, E);
    }
    SEAM(4);
    if (IN(5)) {
        const int gw = blockIdx.x * NWAVES + wave, NGW = G * NWAVES;
        for (int mrow = gw; mrow < MT; mrow += NGW) rms_row_resid(x + (size_t)mrow * DM, U + (size_t)mrow * DM, final_w, a.out + (size_t)mrow * DM, 1e-6f, lane);
    }
}

extern "C" void kernel_launch(void* const* d_in, const int* in_sizes, int n_in, void* d_out, int out_size, void* d_ws, size_t ws_size, hipStream_t stream) {
    static int grid = 0;
    if (!grid) {
        if (n_in != 14 || out_size != MT * DM || ws_size < WS_END) { fprintf(stderr, "kernel_launch: unexpected shapes (n_in %d, out %d, ws %zu)\n", n_in, out_size, ws_size); return; }
        int dev = 0, cus = 0, per_cu = 0;
        hipGetDevice(&dev); hipDeviceGetAttribute(&cus, hipDeviceAttributeMultiprocessorCount, dev);
        hipFuncSetAttribute((const void*)mega_fwd, hipFuncAttributeMaxDynamicSharedMemorySize, LDS_BYTES);
        hipOccupancyMaxActiveBlocksPerMultiprocessor(&per_cu, (const void*)mega_fwd, NTHR, LDS_BYTES);
        if (per_cu < 1) { fprintf(stderr, "kernel_launch: occupancy query says %d blocks per CU\n", per_cu); per_cu = 1; }
        grid = cus * per_cu;
        if (grid % 8 != 0 || grid <= 0) { fprintf(stderr, "kernel_launch: odd grid %d\n", grid); }
    }
    if (hipMemsetAsync(d_ws, 0, 32768, stream) != hipSuccess) { fprintf(stderr, "kernel_launch: memset of the control words failed\n"); return; }
    Args a{};
    for (int i = 0; i < 14; ++i) a.in[i] = (const float*)d_in[i];
    a.out = (float*)d_out; a.ws = (unsigned char*)d_ws;
#if MK_N_LAUNCHES == 1
    a.ph_lo = 0; a.ph_hi = 6;
    void* args[] = {&a};
    hipError_t e = hipLaunchCooperativeKernel((const void*)mega_fwd, dim3(grid), dim3(NTHR), args, LDS_BYTES, stream);
    if (e != hipSuccess) fprintf(stderr, "cooperative launch failed: %s (grid %d)\n", hipGetErrorString(e), grid);
#else
    for (int ph = 0; ph < 6; ++ph) { a.ph_lo = ph; a.ph_hi = ph + 1; hipLaunchKernelGGL(mega_fwd, dim3(grid), dim3(NTHR), LDS_BYTES, stream, a); }
#endif
}
```
